# Optimizing an MI355X kernel written in HIP

```python
import math
import jax, jax.numpy as jnp
from jax import lax
import numpy as np

D_MODEL = 1024
BATCH = 4
SEQ = 8192
DEPTH = 1

DA_HEADS = 8
DA_HEAD_DIM = 64
DA_V_DIM = 2 * DA_HEAD_DIM
DA_QK_WIDTH = DA_HEADS * 2 * DA_HEAD_DIM
DA_V_WIDTH = DA_HEADS * DA_V_DIM
ROPE_THETA = 500000.0
ROT_DIM = DA_HEAD_DIM // 4
Q_BLOCK = 128
SG_GROUPS = 8
SG_CHUNK = 128
SG_WIDTH = 1024
SG_GROUP_DIM = SG_WIDTH // SG_GROUPS
MEM_LEN = 256
XA_HEADS = 4
XA_HEAD_DIM = 256
XA_WIDTH = XA_HEADS * XA_HEAD_DIM
N_BRANCHES = 3
D_FF = int(math.ceil(8 * D_MODEL / 3 / 256)) * 256
ALPHA = (2 * DEPTH) ** 0.25
BETA = (8 * DEPTH) ** -0.25
LN_EPS = 1e-5
RMS_EPS = 1e-5

SPLIT_SIZES = (DA_QK_WIDTH, DA_QK_WIDTH, DA_V_WIDTH, SG_WIDTH, SG_WIDTH, XA_WIDTH, N_BRANCHES * D_MODEL)
SPLIT_POINTS = [int(i) for i in np.cumsum(SPLIT_SIZES)[:-1]]
IN_WIDTH = int(sum(SPLIT_SIZES))

kernel_name = "hybrid_diffattn_sgu_memxattn_deepnorm"


def layer_norm(x, g, b):
    xf = x.astype(jnp.float32)
    mu = jnp.mean(xf, axis=-1, keepdims=True)
    var = jnp.mean(jnp.square(xf - mu), axis=-1, keepdims=True)
    y = (xf - mu) * lax.rsqrt(var + LN_EPS) * g.astype(jnp.float32) + b.astype(jnp.float32)
    return y.astype(x.dtype)


def rms_norm(x, g):
    xf = x.astype(jnp.float32)
    y = xf * lax.rsqrt(jnp.mean(jnp.square(xf), axis=-1, keepdims=True) + RMS_EPS) * g.astype(jnp.float32)
    return y.astype(x.dtype)


def apply_partial_rope(t, cos, sin):
    half = ROT_DIM // 2
    t1 = t[..., :half].astype(jnp.float32)
    t2 = t[..., half:ROT_DIM].astype(jnp.float32)
    rot = jnp.concatenate([t1 * cos - t2 * sin, t2 * cos + t1 * sin], axis=-1).astype(t.dtype)
    return jnp.concatenate([rot, t[..., ROT_DIM:]], axis=-1)


def diff_attention(q, k, v, lam):
    B, H, _, S, dh = q.shape
    dv = v.shape[-1]
    nblk = S // Q_BLOCK
    scale = dh ** -0.5
    qb = q.reshape(B, H, 2, nblk, Q_BLOCK, dh).transpose(3, 0, 1, 2, 4, 5)
    kpos = jnp.arange(S)

    def one_block(args):
        qblk, start = args
        s = jnp.einsum('bhmqd,bhmkd->bhmqk', qblk, k).astype(jnp.float32) * scale
        qpos = start + jnp.arange(Q_BLOCK)
        causal = kpos[None, :] <= qpos[:, None]
        p = jax.nn.softmax(jnp.where(causal, s, -jnp.inf), axis=-1)
        w = p[:, :, 0] - lam * p[:, :, 1]
        return jnp.einsum('bhqk,bhkd->bhqd', w.astype(v.dtype), v)

    starts = jnp.arange(nblk) * Q_BLOCK
    out = lax.map(one_block, (qb, starts))
    return out.transpose(1, 2, 0, 3, 4).reshape(B, H, S, dv)


def spatial_gating(u, v, w_s, b_s, norm_g, norm_b):
    B, S, _ = u.shape
    nc = S // SG_CHUNK
    v = layer_norm(v, norm_g, norm_b)
    vc = v.reshape(B, nc, SG_CHUNK, SG_GROUPS, SG_GROUP_DIM)
    causal = jnp.tril(jnp.ones((SG_CHUNK, SG_CHUNK), dtype=bool))
    ws = jnp.where(causal[None], w_s, jnp.zeros_like(w_s))
    s = jnp.einsum('gts,bcsgd->bctgd', ws, vc) + b_s.T[None, None, :, :, None]
    return u * s.reshape(B, S, SG_WIDTH)


def memory_cross_attention(xq, mem_kv):
    B, S, _ = xq.shape
    M = mem_kv.shape[1]
    q = xq.reshape(B, S, XA_HEADS, XA_HEAD_DIM)
    k, v = jnp.split(mem_kv, 2, axis=-1)
    k = k.reshape(B, M, XA_HEADS, XA_HEAD_DIM)
    v = v.reshape(B, M, XA_HEADS, XA_HEAD_DIM)
    s = jnp.einsum('bshd,bmhd->bhsm', q, k).astype(jnp.float32) * (XA_HEAD_DIM ** -0.5)
    p = jax.nn.softmax(s, axis=-1).astype(v.dtype)
    return jnp.einsum('bhsm,bmhd->bshd', p, v).reshape(B, S, XA_WIDTH)


def setup_inputs(seed: int = 0) -> dict:
    key = jax.random.key(seed)
    ks = jax.random.split(key, 32)
    f32 = jnp.float32
    L, D = DEPTH, D_MODEL

    def nrm(k, shape, scale):
        return jax.random.normal(k, shape, f32) * scale

    x = nrm(ks[0], (BATCH, SEQ, D), 1.0)
    mem = nrm(ks[1], (BATCH, MEM_LEN, D), 1.0)
    offsets = jax.random.randint(ks[2], (BATCH, 1), 0, 1024, dtype=jnp.int32)
    positions = (jnp.arange(SEQ, dtype=jnp.int32)[None, :] + offsets).astype(jnp.int32)
    return {
        "x": x,
        "mem": mem,
        "positions": positions,
        "w_in": nrm(ks[3], (L, D, IN_WIDTH), D ** -0.5),
        "lambda_q1": nrm(ks[4], (L, DA_HEAD_DIM), 0.1),
        "lambda_k1": nrm(ks[5], (L, DA_HEAD_DIM), 0.1),
        "lambda_q2": nrm(ks[6], (L, DA_HEAD_DIM), 0.1),
        "lambda_k2": nrm(ks[7], (L, DA_HEAD_DIM), 0.1),
        "da_subln_g": 1.0 + nrm(ks[8], (L, DA_V_DIM), 0.02),
        "sg_norm_g": 1.0 + nrm(ks[9], (L, SG_WIDTH), 0.02),
        "sg_norm_b": nrm(ks[10], (L, SG_WIDTH), 0.02),
        "sg_w_s": nrm(ks[11], (L, SG_GROUPS, SG_CHUNK, SG_CHUNK), SG_CHUNK ** -0.5),
        "sg_b_s": 1.0 + nrm(ks[12], (L, SG_GROUPS, SG_CHUNK), 0.1),
        "w_mem_kv": nrm(ks[13], (L, D, 2 * XA_WIDTH), D ** -0.5),
        "w_br_attn": nrm(ks[14], (L, DA_V_WIDTH, D), DA_V_WIDTH ** -0.5),
        "w_br_sg": nrm(ks[15], (L, SG_WIDTH, D), SG_WIDTH ** -0.5),
        "w_br_mem": nrm(ks[16], (L, XA_WIDTH, D), XA_WIDTH ** -0.5),
        "w_out": nrm(ks[17], (L, D, D), BETA * D ** -0.5),
        "ln1_g": 1.0 + nrm(ks[18], (L, D), 0.02),
        "ln1_b": nrm(ks[19], (L, D), 0.02),
        "w_ffn_in": nrm(ks[20], (L, D, 2 * D_FF), D ** -0.5),
        "w_ffn_out": nrm(ks[21], (L, D_FF, D), BETA * D_FF ** -0.5),
        "ln2_g": 1.0 + nrm(ks[22], (L, D), 0.02),
        "ln2_b": nrm(ks[23], (L, D), 0.02),
    }


def reference(x, mem, positions, w_in, lambda_q1, lambda_k1, lambda_q2, lambda_k2, da_subln_g,
              sg_norm_g, sg_norm_b, sg_w_s, sg_b_s, w_mem_kv, w_br_attn, w_br_sg, w_br_mem, w_out,
              ln1_g, ln1_b, w_ffn_in, w_ffn_out, ln2_g, ln2_b):
    B, S, D = x.shape
    f32 = jnp.float32
    half = ROT_DIM // 2
    inv_freq = ROPE_THETA ** (-jnp.arange(half, dtype=f32) * 2.0 / ROT_DIM)
    ang = positions.astype(f32)[..., None] * inv_freq
    cos = jnp.cos(ang)[:, :, None, None, :]
    sin = jnp.sin(ang)[:, :, None, None, :]

    for l in range(DEPTH):
        lambda_init = 0.8 - 0.6 * math.exp(-0.3 * l)
        z = x @ w_in[l]
        q, k, v, su, sv, xq, gl = jnp.split(z, SPLIT_POINTS, axis=-1)

        q = apply_partial_rope(q.reshape(B, S, DA_HEADS, 2, DA_HEAD_DIM), cos, sin)
        k = apply_partial_rope(k.reshape(B, S, DA_HEADS, 2, DA_HEAD_DIM), cos, sin)
        q = q.transpose(0, 2, 3, 1, 4)
        k = k.transpose(0, 2, 3, 1, 4)
        va = v.reshape(B, S, DA_HEADS, DA_V_DIM).transpose(0, 2, 1, 3)
        lam = (jnp.exp(jnp.sum(lambda_q1[l].astype(f32) * lambda_k1[l].astype(f32)))
               - jnp.exp(jnp.sum(lambda_q2[l].astype(f32) * lambda_k2[l].astype(f32)))
               + lambda_init)
        o_da = diff_attention(q, k, va, lam)
        o_da = rms_norm(o_da, da_subln_g[l]) * (1.0 - lambda_init)
        o_da = o_da.transpose(0, 2, 1, 3).reshape(B, S, DA_V_WIDTH)

        o_sg = spatial_gating(jax.nn.gelu(su), jax.nn.gelu(sv), sg_w_s[l], sg_b_s[l],
                              sg_norm_g[l], sg_norm_b[l])

        o_xa = memory_cross_attention(xq, mem @ w_mem_kv[l])

        g = jax.nn.sigmoid(gl).reshape(B, S, N_BRANCHES, D)
        merged = (g[:, :, 0] * (o_da @ w_br_attn[l])
                  + g[:, :, 1] * (o_sg @ w_br_sg[l])
                  + g[:, :, 2] * (o_xa @ w_br_mem[l]))
        x = layer_norm(ALPHA * x + merged @ w_out[l], ln1_g[l], ln1_b[l])

        a, b = jnp.split(x @ w_ffn_in[l], 2, axis=-1)
        x = layer_norm(ALPHA * x + (jax.nn.silu(a) * b) @ w_ffn_out[l], ln2_g[l], ln2_b[l])
    return x
```

```cpp
#include <hip/hip_runtime.h>
#include <hip/hip_cooperative_groups.h>
#include <cstdio>
#include <cstdint>
namespace cg = cooperative_groups;
namespace pg8 {
#define PG8_LAS __attribute__((address_space(3)))
typedef unsigned short bf16_t;
typedef short bf16x8 __attribute__((ext_vector_type(8)));
typedef float f32x4 __attribute__((ext_vector_type(4)));
typedef unsigned u32x4 __attribute__((ext_vector_type(4)));
constexpr int BM = 256, BK = 64, HALF = 128, HTB = HALF * BK * 2  , STAGE_BYTES = 8 * HTB, NXCD = 8, WGM = 8;

__host__ __device__ __forceinline__ int lds_byte(int r, int c) { const int st = (r >> 4) * 2 + (c >> 5), rr = r & 15, cc = c & 31, ob = rr * 64 + cc * 2; return st * 1024 + (ob ^ (((ob >> 9) & 1) << 5)); }
__host__ __device__ __forceinline__ void stage_rc(int b, int& R, int& C) { const int st = b / 1024, sb = b % 1024, swz = sb ^ (((sb >> 9) & 1) << 5); R = (st >> 1) * 16 + swz / 64; C = (st & 1) * 32 + (swz % 64) / 2; }
__host__ __device__ __forceinline__ int perm32(int rho) { const int n = rho >> 4, i = rho & 15; return 8 * (i >> 2) + 4 * n + (i & 3); }

struct Unit { int pm, pn; };
struct Gemm { const bf16_t* A; const bf16_t* Bt; int M, N, K; };

struct StaticOrder {
    int nM, nN, nwg, G, c;
    __host__ __device__ void init(int M, int N, int G_, int c_) { nM = M / BM; nN = N / BM; nwg = nM * nN; G = G_; c = c_; }
    __host__ __device__ bool next(int i, Unit& u) const {
        const long L = (long)i * G + c; if (L >= nwg) return false;
        int wgid = (int)L; { const int q = nwg / NXCD, r = nwg % NXCD, xcd = wgid % NXCD, off = wgid / NXCD; wgid = (xcd < r ? xcd * (q + 1) : r * (q + 1) + (xcd - r) * q) + off; }
        const int nig = WGM * nN, gid = wgid / nig, fm = gid * WGM, gsz = (nM - fm) < WGM ? (nM - fm) : WGM;
        u.pm = fm + ((wgid % nig) % gsz); u.pn = (wgid % nig) / gsz; return true;
    }
    __device__ __forceinline__ void a_ready(const Unit&) const {}
    __device__ __forceinline__ void done(const Unit&) const {}
};

__device__ __forceinline__ unsigned cvt_pk_bf16(float lo, float hi) { unsigned r; asm volatile("v_cvt_pk_bf16_f32 %0, %1, %2" : "=v"(r) : "v"(lo), "v"(hi)); return r; }
typedef float f32x2 __attribute__((ext_vector_type(2)));
template <class Epi, class Sched, bool ALIGN_EPI = false, bool SP2 = false>
__device__ __forceinline__ void gemm_phase(PG8_LAS unsigned char* lds, const Gemm g, const Sched& S, const Epi& E) {
    const int tid = threadIdx.x, wid = __builtin_amdgcn_readfirstlane(tid >> 6), lane = tid & 63, wr = wid >> 2, wc = wid & 3, fr = lane & 15, fq = lane >> 4;
    const int K = g.K, nt = K / BK;
    unsigned voffA[2], voffB[2];
#pragma unroll
    for (int i = 0; i < 2; ++i) { int R, C; stage_rc(tid * 16 + i * 8192, R, C); const int Rb = Epi::PERM ? ((R & ~31) + perm32(R & 31)) : R;
        voffA[i] = (unsigned)(R * K + C) * 2u; voffB[i] = (unsigned)(Rb * K + C) * 2u; }
    const size_t kstep = (size_t)(BK * 2);
    const size_t hstep = (size_t)HALF * K * 2;
    const size_t tstep = 2 * hstep;
    const unsigned ldsw = (unsigned)wid * 1024u;
    const int aoff = lds_byte(wr * 64 + fr, fq * 8), boff = lds_byte(wc * 32 + fr, fq * 8);
#define PG8_SA(b, h) (((b) * 2 + (h)) * HTB)
#define PG8_SB(b, h) ((4 + (b) * 2 + (h)) * HTB)
#define PG8_STAGE(bufoff, gbase, voff) do { _Pragma("unroll") for (int _i = 0; _i < 2; ++_i) \
        __builtin_amdgcn_global_load_lds((const unsigned*)((const char*)(gbase) + (voff)[_i]), (PG8_LAS unsigned*)(lds + (bufoff) + ldsw + _i * 8192), 16, 0, 0); } while (0)
#define PG8_LDA(dst, b, h) do { _Pragma("unroll") for (int m = 0; m < 4; ++m) _Pragma("unroll") for (int k = 0; k < 2; ++k) dst[m][k] = *(const PG8_LAS bf16x8*)(lds + PG8_SA(b, h) + aoff + m * 2048 + k * 1024); } while (0)
#define PG8_LDB(dst, b, h) do { _Pragma("unroll") for (int n = 0; n < 2; ++n) _Pragma("unroll") for (int k = 0; k < 2; ++k) dst[n][k] = *(const PG8_LAS bf16x8*)(lds + PG8_SB(b, h) + boff + n * 2048 + k * 1024); } while (0)
#define PG8_MMA(ai, bj, At, Bt) do { __builtin_amdgcn_s_setprio(1); _Pragma("unroll") for (int m = 0; m < 4; ++m) _Pragma("unroll") for (int n = 0; n < 2; ++n) _Pragma("unroll") for (int k = 0; k < 2; ++k) \
        acc[ai][bj][m][n] = __builtin_amdgcn_mfma_f32_16x16x32_bf16(Bt[n][k], At[m][k], acc[ai][bj][m][n], 0, 0, 0); __builtin_amdgcn_s_setprio(0); } while (0)
#define PG8_WAIT_V(n) asm volatile("s_waitcnt vmcnt(" #n ")" ::: "memory")
#define PG8_WAIT_L(n) asm volatile("s_waitcnt lgkmcnt(" #n ")" ::: "memory")
#define PG8_BAR __builtin_amdgcn_s_barrier()
#define PG8_SCHED __builtin_amdgcn_sched_barrier(0)
    Unit cur, nxt; int ui = 0;
    if (!S.next(0, cur)) return;
    f32x4 acc[2][2][4][2];
#pragma unroll
    for (int a = 0; a < 2; ++a)
#pragma unroll
        for (int b = 0; b < 2; ++b)
#pragma unroll
            for (int m = 0; m < 4; ++m)
#pragma unroll
                for (int n = 0; n < 2; ++n) acc[a][b][m][n] = (f32x4){0.f, 0.f, 0.f, 0.f};
    bf16x8 At[4][2], B0[2][2], B1[2][2];
    const char* cA = (const char*)g.A + (size_t)cur.pm * tstep; const char* cB = (const char*)g.Bt + (size_t)cur.pn * tstep;
    S.a_ready(cur);
    if constexpr (SP2) {
        PG8_STAGE(PG8_SB(0, 0), cB, voffB); PG8_STAGE(PG8_SB(0, 1), cB + hstep, voffB); PG8_STAGE(PG8_SA(0, 0), cA, voffA); PG8_STAGE(PG8_SA(0, 1), cA + hstep, voffA);
        if (wr == 1) PG8_BAR;
        PG8_WAIT_V(2); PG8_BAR;
        PG8_STAGE(PG8_SB(1, 0), cB + kstep, voffB); PG8_STAGE(PG8_SA(1, 0), cA + kstep, voffA); PG8_STAGE(PG8_SB(1, 1), cB + hstep + kstep, voffB);
        PG8_WAIT_V(6); PG8_BAR;
    } else {
        PG8_STAGE(PG8_SB(0, 0), cB, voffB); PG8_STAGE(PG8_SA(0, 0), cA, voffA); PG8_STAGE(PG8_SB(0, 1), cB + hstep, voffB); PG8_STAGE(PG8_SA(0, 1), cA + hstep, voffA);
        if (wr == 1) PG8_BAR;
        PG8_WAIT_V(4); PG8_BAR;
        PG8_STAGE(PG8_SB(1, 0), cB + kstep, voffB); PG8_STAGE(PG8_SA(1, 0), cA + kstep, voffA); PG8_STAGE(PG8_SB(1, 1), cB + hstep + kstep, voffB);
        PG8_WAIT_V(6); PG8_BAR;
    }
    for (;;) {
        const bool has_next = S.next(ui + 1, nxt);
        const char* nA = has_next ? (const char*)g.A + (size_t)nxt.pm * tstep : cA; const char* nB = has_next ? (const char*)g.Bt + (size_t)nxt.pn * tstep : cB;
        for (int t = 0; t < nt; t += 2) {
            const bool last = (t == nt - 2);
            const char* a1 = cA + (size_t)(t + 1) * kstep;
            const char* a2 = last ? nA : cA + (size_t)(t + 2) * kstep; const char* b2 = last ? nB : cB + (size_t)(t + 2) * kstep;
            const char* a3 = a2 + kstep; const char* b3 = b2 + kstep;
            if (last && has_next) S.a_ready(nxt);
            if constexpr (SP2) {
            PG8_LDB(B0, 0, 0); PG8_LDB(B1, 0, 1); PG8_SCHED; PG8_LDA(At, 0, 0); PG8_STAGE(PG8_SA(1, 1), a1 + hstep, voffA);
            PG8_WAIT_V(8); PG8_WAIT_L(0); PG8_BAR; PG8_MMA(0, 0, At, B0); PG8_MMA(0, 1, At, B1); PG8_BAR; PG8_SCHED;
            PG8_LDA(At, 0, 1); PG8_STAGE(PG8_SB(0, 0), b2, voffB); PG8_STAGE(PG8_SB(0, 1), b2 + hstep, voffB); PG8_STAGE(PG8_SA(0, 0), a2, voffA);
            PG8_WAIT_V(8); PG8_WAIT_L(0); PG8_BAR; PG8_MMA(1, 0, At, B0); PG8_MMA(1, 1, At, B1); PG8_BAR; PG8_SCHED;
            PG8_LDB(B0, 1, 0); PG8_LDB(B1, 1, 1); PG8_SCHED; PG8_LDA(At, 1, 0); PG8_STAGE(PG8_SA(0, 1), a2 + hstep, voffA);
            PG8_WAIT_V(8); PG8_WAIT_L(0); PG8_BAR; PG8_MMA(0, 0, At, B0); PG8_MMA(0, 1, At, B1); PG8_BAR; PG8_SCHED;
            PG8_LDA(At, 1, 1); PG8_STAGE(PG8_SB(1, 0), b3, voffB); PG8_STAGE(PG8_SB(1, 1), b3 + hstep, voffB); PG8_STAGE(PG8_SA(1, 0), a3, voffA);
            PG8_WAIT_V(8); PG8_WAIT_L(0); PG8_BAR; PG8_MMA(1, 0, At, B0); PG8_MMA(1, 1, At, B1); PG8_BAR; PG8_SCHED;
            } else {
            PG8_LDB(B0, 0, 0); PG8_SCHED; PG8_LDA(At, 0, 0); PG8_STAGE(PG8_SA(1, 1), a1 + hstep, voffA);
            PG8_WAIT_L(8); PG8_BAR; PG8_WAIT_L(0); PG8_MMA(0, 0, At, B0); PG8_BAR; PG8_SCHED;
            PG8_LDB(B1, 0, 1); PG8_STAGE(PG8_SB(0, 0), b2, voffB);
            PG8_BAR; PG8_WAIT_L(0); PG8_MMA(0, 1, At, B1); PG8_BAR;
            PG8_LDA(At, 0, 1); PG8_STAGE(PG8_SA(0, 0), a2, voffA);
            PG8_BAR; PG8_WAIT_L(0); PG8_MMA(1, 0, At, B0); PG8_BAR; PG8_SCHED;
            PG8_STAGE(PG8_SB(0, 1), b2 + hstep, voffB);
            PG8_WAIT_V(6); PG8_BAR; PG8_MMA(1, 1, At, B1); PG8_BAR;
            PG8_LDB(B0, 1, 0); PG8_SCHED; PG8_LDA(At, 1, 0); PG8_STAGE(PG8_SA(0, 1), a2 + hstep, voffA);
            PG8_WAIT_L(8); PG8_BAR; PG8_WAIT_L(0); PG8_MMA(0, 0, At, B0); PG8_BAR; PG8_SCHED;
            PG8_LDB(B1, 1, 1); PG8_STAGE(PG8_SB(1, 0), b3, voffB);
            PG8_BAR; PG8_WAIT_L(0); PG8_MMA(0, 1, At, B1); PG8_BAR;
            PG8_LDA(At, 1, 1); PG8_STAGE(PG8_SA(1, 0), a3, voffA);
            PG8_BAR; PG8_WAIT_L(0); PG8_MMA(1, 0, At, B0); PG8_BAR; PG8_SCHED;
            PG8_STAGE(PG8_SB(1, 1), b3 + hstep, voffB);
            PG8_WAIT_V(6); PG8_BAR; PG8_MMA(1, 1, At, B1); PG8_BAR;
            }
        }
        if constexpr (ALIGN_EPI) { if (wr == 0) PG8_BAR; }
        if constexpr (!Epi::AFTER_DRAIN) { E(acc, cur, wr, wc, fr, fq); S.done(cur); }
        if (!has_next) break;
#pragma unroll
        for (int a = 0; a < 2; ++a)
#pragma unroll
            for (int b = 0; b < 2; ++b)
#pragma unroll
                for (int m = 0; m < 4; ++m)
#pragma unroll
                    for (int n = 0; n < 2; ++n) acc[a][b][m][n] = (f32x4){0.f, 0.f, 0.f, 0.f};
        cur = nxt; cA = nA; cB = nB; ++ui;
        if constexpr (ALIGN_EPI) { if (wr == 1) PG8_BAR; }
    }
    PG8_WAIT_V(0);
    if constexpr (!ALIGN_EPI) { if (wr == 0) PG8_BAR; }
    PG8_BAR;
    if constexpr (Epi::AFTER_DRAIN) { E.fused(acc, cur, wr, wc, fr, fq, lds, wid, lane); S.done(cur); }
#undef PG8_SA
#undef PG8_SB
#undef PG8_STAGE
#undef PG8_LDA
#undef PG8_LDB
#undef PG8_MMA
#undef PG8_WAIT_V
#undef PG8_WAIT_L
#undef PG8_BAR
#undef PG8_SCHED
}
}

constexpr int BATCH = 4, SEQ = 8192, DM = 1024, MTOK = BATCH * SEQ;
constexpr int MEMLEN = 256, DFF = 2816, NIN = 9216;
constexpr float ALPHA_RES = 1.189207115002721f;
constexpr float LOG2E = 1.4426950408889634f;
constexpr float QSCALE = 0.125f * LOG2E;
constexpr float XQSCALE = 0.0625f * LOG2E;
constexpr size_t MiB = 1u << 20, SLOT = 64 * MiB, SLOT_ELEMS = SLOT / 2;
constexpr size_t WS_WIN = 0, WS_WMKV = 18 * MiB, WS_WBR = 22 * MiB, WS_WOUT = 28 * MiB, WS_WFFI = 30 * MiB, WS_WFFO = 41 * MiB,
                 WS_MKV = 47 * MiB, WS_MEMB = 51 * MiB, WS_ROPE = 53 * MiB;
constexpr int LDS_BYTES = 147456;

typedef unsigned short bf16_t;
typedef short bf16x8 __attribute__((ext_vector_type(8)));
typedef short s16x4 __attribute__((ext_vector_type(4)));
typedef float f32x4 __attribute__((ext_vector_type(4)));
typedef float f32x16 __attribute__((ext_vector_type(16)));
typedef unsigned u32x4 __attribute__((ext_vector_type(4)));
typedef unsigned u32x2 __attribute__((ext_vector_type(2)));
#define LAS __attribute__((address_space(3)))
typedef LAS const char* lds_cptr;

__device__ __forceinline__ float bf2f(unsigned short b) { return __uint_as_float((unsigned)b << 16); }
__device__ __forceinline__ float bflo(unsigned w) { return __uint_as_float(w << 16); }
__device__ __forceinline__ float bfhi(unsigned w) { return __uint_as_float(w & 0xffff0000u); }
__device__ __forceinline__ unsigned pk(float lo, float hi) { return pg8::cvt_pk_bf16(lo, hi); }
__device__ __forceinline__ float fexp2(float x) { return __builtin_amdgcn_exp2f(x); }
__device__ __forceinline__ float frcp(float x) { return __builtin_amdgcn_rcpf(x); }
__device__ __forceinline__ float sigmoid_f(float x) { return frcp(1.0f + fexp2(-LOG2E * x)); }
__device__ __forceinline__ float silu_f(float x) { return x * sigmoid_f(x); }
__device__ __forceinline__ float gelu_tanh_f(float x) {
    const float u = 0.7978845608028654f * (x + 0.044715f * x * x * x);
    return x * frcp(1.0f + fexp2(-2.0f * LOG2E * u));
}
__device__ __forceinline__ float wave_sum(float v) {
#pragma unroll
    for (int o = 1; o < 64; o <<= 1) v += __shfl_xor(v, o);
    return v;
}

namespace pg8 {
struct EpiA {
    static constexpr bool PERM = true, AFTER_DRAIN = false;
    bf16_t* out0; const float* rope;
    __device__ __forceinline__ void operator()(const f32x4 (&acc)[2][2][4][2], const Unit& u, int wr, int wc, int fr, int fq) const {
        const int t = u.pn >> 2;
        bf16_t* base = out0 + (size_t)t * SLOT_ELEMS;
        const int row0 = u.pm * BM + wr * 64 + fr, col0 = (u.pn & 3) * BM + wc * 32 + 8 * fq;
        const bool do_rope = (t <= 1) && ((wc & 1) == 0);
        const float sgn = (fq == 0) ? -1.f : 1.f;
#pragma unroll
        for (int ai = 0; ai < 2; ++ai)
#pragma unroll
            for (int m = 0; m < 4; ++m) {
                const int row = row0 + ai * HALF + m * 16;
                bf16_t* rowp = base + (size_t)row * 1024 + col0;
                f32x4 cs0, cs1, sn0, sn1;
                if (do_rope) { const f32x4* rp = (const f32x4*)(rope + (size_t)row * 16); cs0 = rp[0]; cs1 = rp[1]; sn0 = rp[2]; sn1 = rp[3]; }
#pragma unroll
                for (int bj = 0; bj < 2; ++bj) {
                    f32x4 v0 = acc[ai][bj][m][0], v1 = acc[ai][bj][m][1];
                    if (do_rope) {
                        f32x4 p0, p1;
#pragma unroll
                        for (int j = 0; j < 4; ++j) { p0[j] = __shfl_xor(v0[j], 16); p1[j] = __shfl_xor(v1[j], 16); }
                        if (fq < 2) { v0 = v0 * cs0 + sgn * (p0 * sn0); v1 = v1 * cs1 + sgn * (p1 * sn1); }
                    }
                    if (t == 0) { v0 = v0 * QSCALE; v1 = v1 * QSCALE; }
                    else if (t == 5) { v0 = v0 * XQSCALE; v1 = v1 * XQSCALE; }
                    else if (t == 3 || t == 4) {
#pragma unroll
                        for (int j = 0; j < 4; ++j) { v0[j] = gelu_tanh_f(v0[j]); v1[j] = gelu_tanh_f(v1[j]); }
                    }
                    u32x4 w; w.x = cvt_pk_bf16(v0[0], v0[1]); w.y = cvt_pk_bf16(v0[2], v0[3]); w.z = cvt_pk_bf16(v1[0], v1[1]); w.w = cvt_pk_bf16(v1[2], v1[3]);
                    *(u32x4*)(rowp + bj * HALF) = w;
                }
            }
    }
};
template <int ACT> struct EpiStore {
    static constexpr bool PERM = true, AFTER_DRAIN = false;
    bf16_t* O; int ldc;
    __device__ __forceinline__ void operator()(const f32x4 (&acc)[2][2][4][2], const Unit& u, int wr, int wc, int fr, int fq) const {
        const int row0 = u.pm * BM + wr * 64 + fr, col0 = u.pn * BM + wc * 32 + 8 * fq;
#pragma unroll
        for (int ai = 0; ai < 2; ++ai)
#pragma unroll
            for (int m = 0; m < 4; ++m) {
                bf16_t* rowp = O + (size_t)(row0 + ai * HALF + m * 16) * ldc + col0;
#pragma unroll
                for (int bj = 0; bj < 2; ++bj) {
                    f32x4 v0 = acc[ai][bj][m][0], v1 = acc[ai][bj][m][1];
                    if (ACT == 1) {
#pragma unroll
                        for (int j = 0; j < 4; ++j) { v0[j] = sigmoid_f(v0[j]); v1[j] = sigmoid_f(v1[j]); }
                    }
                    u32x4 w; w.x = cvt_pk_bf16(v0[0], v0[1]); w.y = cvt_pk_bf16(v0[2], v0[3]); w.z = cvt_pk_bf16(v1[0], v1[1]); w.w = cvt_pk_bf16(v1[2], v1[3]);
                    *(u32x4*)(rowp + bj * HALF) = w;
                }
            }
    }
};
struct EpiMerge {
    static constexpr bool PERM = true, AFTER_DRAIN = false;
    const bf16_t* G; bf16_t* MG; int first;
    __device__ __forceinline__ void operator()(const f32x4 (&acc)[2][2][4][2], const Unit& u, int wr, int wc, int fr, int fq) const {
        const int row0 = u.pm * BM + wr * 64 + fr, col0 = u.pn * BM + wc * 32 + 8 * fq;
#pragma unroll
        for (int ai = 0; ai < 2; ++ai)
#pragma unroll
            for (int m = 0; m < 4; ++m) {
                const size_t off = (size_t)(row0 + ai * HALF + m * 16) * 1024 + col0;
#pragma unroll
                for (int bj = 0; bj < 2; ++bj) {
                    const f32x4 v0 = acc[ai][bj][m][0], v1 = acc[ai][bj][m][1];
                    const u32x4 g = *(const u32x4*)(G + off + bj * HALF);
                    float r[8];
                    r[0] = bflo(g.x) * v0[0]; r[1] = bfhi(g.x) * v0[1]; r[2] = bflo(g.y) * v0[2]; r[3] = bfhi(g.y) * v0[3];
                    r[4] = bflo(g.z) * v1[0]; r[5] = bfhi(g.z) * v1[1]; r[6] = bflo(g.w) * v1[2]; r[7] = bfhi(g.w) * v1[3];
                    if (!first) {
                        const u32x4 o = *(const u32x4*)(MG + off + bj * HALF);
                        r[0] += bflo(o.x); r[1] += bfhi(o.x); r[2] += bflo(o.y); r[3] += bfhi(o.y);
                        r[4] += bflo(o.z); r[5] += bfhi(o.z); r[6] += bflo(o.w); r[7] += bfhi(o.w);
                    }
                    u32x4 w; w.x = cvt_pk_bf16(r[0], r[1]); w.y = cvt_pk_bf16(r[2], r[3]); w.z = cvt_pk_bf16(r[4], r[5]); w.w = cvt_pk_bf16(r[6], r[7]);
                    *(u32x4*)(MG + off + bj * HALF) = w;
                }
            }
    }
};
struct EpiGM {
    static constexpr bool PERM = true, AFTER_DRAIN = false;
    bf16_t* G; bf16_t* MG; int mode;
    __device__ __forceinline__ void operator()(const f32x4 (&acc)[2][2][4][2], const Unit& u, int wr, int wc, int fr, int fq) const {
        const int row0 = u.pm * BM + wr * 64 + fr, col0 = u.pn * BM + wc * 32 + 8 * fq;
#pragma unroll
        for (int ai = 0; ai < 2; ++ai)
#pragma unroll
            for (int m = 0; m < 4; ++m) {
                const size_t off = (size_t)(row0 + ai * HALF + m * 16) * 1024 + col0;
#pragma unroll
                for (int bj = 0; bj < 2; ++bj) {
                    const f32x4 v0 = acc[ai][bj][m][0], v1 = acc[ai][bj][m][1];
                    float r[8];
                    if (mode == 0) {
#pragma unroll
                        for (int j = 0; j < 4; ++j) { r[j] = sigmoid_f(v0[j]); r[4 + j] = sigmoid_f(v1[j]); }
                        u32x4 w; w.x = cvt_pk_bf16(r[0], r[1]); w.y = cvt_pk_bf16(r[2], r[3]); w.z = cvt_pk_bf16(r[4], r[5]); w.w = cvt_pk_bf16(r[6], r[7]);
                        *(u32x4*)(G + off + bj * HALF) = w;
                    } else {
                        const u32x4 g = *(const u32x4*)(G + off + bj * HALF);
                        r[0] = bflo(g.x) * v0[0]; r[1] = bfhi(g.x) * v0[1]; r[2] = bflo(g.y) * v0[2]; r[3] = bfhi(g.y) * v0[3];
                        r[4] = bflo(g.z) * v1[0]; r[5] = bfhi(g.z) * v1[1]; r[6] = bflo(g.w) * v1[2]; r[7] = bfhi(g.w) * v1[3];
                        if (mode == 2) {
                            const u32x4 o = *(const u32x4*)(MG + off + bj * HALF);
                            r[0] += bflo(o.x); r[1] += bfhi(o.x); r[2] += bflo(o.y); r[3] += bfhi(o.y);
                            r[4] += bflo(o.z); r[5] += bfhi(o.z); r[6] += bflo(o.w); r[7] += bfhi(o.w);
                        }
                        u32x4 w; w.x = cvt_pk_bf16(r[0], r[1]); w.y = cvt_pk_bf16(r[2], r[3]); w.z = cvt_pk_bf16(r[4], r[5]); w.w = cvt_pk_bf16(r[6], r[7]);
                        *(u32x4*)(MG + off + bj * HALF) = w;
                    }
                }
            }
    }
};
struct EpiRes32 {
    static constexpr bool PERM = true, AFTER_DRAIN = false;
    const float* base; float* out; float alpha;
    __device__ __forceinline__ void operator()(const f32x4 (&acc)[2][2][4][2], const Unit& u, int wr, int wc, int fr, int fq) const {
        const int row0 = u.pm * BM + wr * 64 + fr, col0 = u.pn * BM + wc * 32 + 8 * fq;
#pragma unroll
        for (int ai = 0; ai < 2; ++ai)
#pragma unroll
            for (int m = 0; m < 4; ++m) {
                const size_t off = (size_t)(row0 + ai * HALF + m * 16) * 1024 + col0;
#pragma unroll
                for (int bj = 0; bj < 2; ++bj) {
                    const f32x4 b0 = *(const f32x4*)(base + off + bj * HALF), b1 = *(const f32x4*)(base + off + bj * HALF + 4);
                    const f32x4 o0 = b0 * alpha + acc[ai][bj][m][0], o1 = b1 * alpha + acc[ai][bj][m][1];
                    *(f32x4*)(out + off + bj * HALF) = o0; *(f32x4*)(out + off + bj * HALF + 4) = o1;
                }
            }
    }
};
struct EpiSwiglu {
    static constexpr bool PERM = true, AFTER_DRAIN = false;
    bf16_t* H;
    __device__ __forceinline__ void operator()(const f32x4 (&acc)[2][2][4][2], const Unit& u, int wr, int wc, int fr, int fq) const {
        const int row0 = u.pm * BM + wr * 64 + fr, col0 = u.pn * HALF + wc * 32 + 8 * fq;
#pragma unroll
        for (int ai = 0; ai < 2; ++ai)
#pragma unroll
            for (int m = 0; m < 4; ++m) {
                bf16_t* p = H + (size_t)(row0 + ai * HALF + m * 16) * DFF + col0;
                float r[8];
#pragma unroll
                for (int j = 0; j < 4; ++j) { r[j] = silu_f(acc[ai][0][m][0][j]) * acc[ai][1][m][0][j]; r[4 + j] = silu_f(acc[ai][0][m][1][j]) * acc[ai][1][m][1][j]; }
                u32x4 w; w.x = cvt_pk_bf16(r[0], r[1]); w.y = cvt_pk_bf16(r[2], r[3]); w.z = cvt_pk_bf16(r[4], r[5]); w.w = cvt_pk_bf16(r[6], r[7]);
                *(u32x4*)p = w;
            }
    }
};
}

__device__ __forceinline__ int crow(int r, int hi) { return (r & 3) + 8 * (r >> 2) + 4 * hi; }
typedef short v4i16_t __attribute__((ext_vector_type(4)));
__device__ __forceinline__ s16x4 vtr(lds_cptr p) { return __builtin_bit_cast(s16x4, __builtin_amdgcn_ds_read_tr16_b64_v4i16((LAS v4i16_t*)p)); }
__device__ __forceinline__ float swapmax(float m) {
    auto rr = __builtin_amdgcn_permlane32_swap(__float_as_uint(m), __float_as_uint(m), false, false);
    return fmaxf(__uint_as_float(rr[0]), __uint_as_float(rr[1]));
}
__device__ __forceinline__ float swapsum(float m) {
    auto rr = __builtin_amdgcn_permlane32_swap(__float_as_uint(m), __float_as_uint(m), false, false);
    return __uint_as_float(rr[0]) + __uint_as_float(rr[1]);
}
__device__ __forceinline__ void scale_rows(f32x16 (&o)[4], LAS float* wsf, float fac, int r32, int hi) {
    if (hi == 0) wsf[r32] = fac;
#pragma unroll
    for (int g = 0; g < 4; ++g) {
        const f32x4 a4 = *(LAS const f32x4*)(wsf + 8 * g + 4 * hi);
#pragma unroll
        for (int j = 0; j < 4; ++j)
#pragma unroll
            for (int db = 0; db < 4; ++db) o[db][4 * g + j] *= a4[j];
    }
}
__device__ __forceinline__ void softmax_pv(f32x16& p0, f32x16& p1, float& m, float& l, f32x16 (&o)[4], LAS float* wsf, lds_cptr vp, int r32, int hi) {
    float rm = fmaxf(p0[0], p1[0]);
#pragma unroll
    for (int r = 1; r < 16; ++r) rm = fmaxf(rm, fmaxf(p0[r], p1[r]));
    rm = swapmax(rm);
    if (__any(rm > m + 8.0f)) {
        const float mn = fmaxf(m, rm);
        const float alpha = fexp2(m - mn);
        m = mn; l *= alpha;
        scale_rows(o, wsf, alpha, r32, hi);
    }
    float s = 0.f;
#pragma unroll
    for (int r = 0; r < 16; ++r) { p0[r] = fexp2(p0[r] - m); p1[r] = fexp2(p1[r] - m); s += p0[r] + p1[r]; }
    l += s;
    u32x4 pw[4];
#pragma unroll
    for (int j = 0; j < 4; ++j) { pw[0][j] = pk(p0[2 * j], p0[2 * j + 1]); pw[1][j] = pk(p0[8 + 2 * j], p0[8 + 2 * j + 1]); pw[2][j] = pk(p1[2 * j], p1[2 * j + 1]); pw[3][j] = pk(p1[8 + 2 * j], p1[8 + 2 * j + 1]); }
#pragma unroll
    for (int db = 0; db < 4; ++db)
#pragma unroll
        for (int ks = 0; ks < 4; ++ks) {
            const s16x4 lo = vtr(vp + db * 4096 + ks * 1024), hh = vtr(vp + db * 4096 + ks * 1024 + 512);
            const bf16x8 vf = (bf16x8){lo[0], lo[1], lo[2], lo[3], hh[0], hh[1], hh[2], hh[3]};
            o[db] = __builtin_amdgcn_mfma_f32_32x32x16_bf16(__builtin_bit_cast(bf16x8, pw[ks]), vf, o[db], 0, 0, 0);
        }
}

constexpr int WSF_OFF = 139264;
constexpr int COMB_OFF = 65536, COMB_STRIDE = 136;

__device__ __forceinline__ void diff_unit(LAS unsigned char* l3, const bf16_t* Q, const bf16_t* K, const bf16_t* V, bf16_t* O, int b, int h, int qb, float lam, const float* subg) {
    const int tid = threadIdx.x, lane = tid & 63, r32 = lane & 31, hi = lane >> 5;
    const int wid = __builtin_amdgcn_readfirstlane(tid >> 6), map = wid & 1, qblk = wid >> 1;
    const long rowbase = (long)b * SEQ; const int q0 = qb * 128;
    const int NT = (q0 + 128) / 64;
    LAS float* wsf = (LAS float*)(l3 + WSF_OFF) + wid * 32;
    const bf16_t* ksrc = K + (rowbase + lane) * 1024 + h * 128 + wid * 8;
    const bf16_t* vsrc = V + (rowbase + 16 * (wid & 3) + (lane >> 2)) * 1024 + h * 128 + (wid >> 2) * 32 + (lane & 3) * 8;
    const int kdst = wid * 1024 + lane * 16, vdst = 16384 + wid * 1024 + lane * 16;
    const bf16_t* Qw = Q + (rowbase + q0 + qblk * 32 + r32) * 1024 + h * 128 + map * 64;
    bf16x8 qr[4];
#pragma unroll
    for (int d0 = 0; d0 < 4; ++d0) qr[d0] = *(const bf16x8*)(Qw + d0 * 16 + hi * 8);
    const lds_cptr kp = (lds_cptr)l3 + map * 8192 + hi * 1024 + r32 * 16;
    const lds_cptr vp = (lds_cptr)l3 + 16384 + ((lane >> 4) & 1) * 32 + (lane & 3) * 8 + (4 * hi + ((lane & 15) >> 2)) * 64;
    float m = -INFINITY, l = 0.f;
    f32x16 o[4];
#pragma unroll
    for (int db = 0; db < 4; ++db)
#pragma unroll
        for (int r = 0; r < 16; ++r) o[db][r] = 0.f;
    u32x4 sk0, sk1, sv0, sv1;
    sk0 = *(const u32x4*)(ksrc); sk1 = *(const u32x4*)(ksrc + 64); sv0 = *(const u32x4*)(vsrc); sv1 = *(const u32x4*)(vsrc + 64);
    *(LAS u32x4*)(l3 + kdst) = sk0; *(LAS u32x4*)(l3 + kdst + 8192) = sk1; *(LAS u32x4*)(l3 + vdst) = sv0; *(LAS u32x4*)(l3 + vdst + 8192) = sv1;
    __syncthreads();
    const int qlast = q0 + qblk * 32 + 31, qg = q0 + qblk * 32 + r32;
    for (int t = 0; t < NT; ++t) {
        const int cur = (t & 1) * 32768, nxt = 32768 - cur;
        const bool more = (t + 1 < NT);
        if (more) { const size_t adv = (size_t)(t + 1) * 64 * 1024;
            sk0 = *(const u32x4*)(ksrc + adv); sk1 = *(const u32x4*)(ksrc + adv + 64); sv0 = *(const u32x4*)(vsrc + adv); sv1 = *(const u32x4*)(vsrc + adv + 64); }
        if (t * 64 <= qlast) {
            f32x16 p0, p1;
#pragma unroll
            for (int r = 0; r < 16; ++r) { p0[r] = 0.f; p1[r] = 0.f; }
#pragma unroll
            for (int d0 = 0; d0 < 4; ++d0) {
                const bf16x8 k0 = *(LAS const bf16x8*)(kp + cur + d0 * 2048), k1 = *(LAS const bf16x8*)(kp + cur + d0 * 2048 + 512);
                p0 = __builtin_amdgcn_mfma_f32_32x32x16_bf16(k0, qr[d0], p0, 0, 0, 0);
                p1 = __builtin_amdgcn_mfma_f32_32x32x16_bf16(k1, qr[d0], p1, 0, 0, 0);
            }
            if (t >= NT - 2) {
                const int kb = t * 64 + 4 * hi;
#pragma unroll
                for (int r = 0; r < 16; ++r) { const int kv = kb + (r & 3) + 8 * (r >> 2); if (kv > qg) p0[r] = -INFINITY; if (kv + 32 > qg) p1[r] = -INFINITY; }
            }
            softmax_pv(p0, p1, m, l, o, wsf, vp + cur, r32, hi);
        }
        if (more) { *(LAS u32x4*)(l3 + nxt + kdst) = sk0; *(LAS u32x4*)(l3 + nxt + kdst + 8192) = sk1; *(LAS u32x4*)(l3 + nxt + vdst) = sv0; *(LAS u32x4*)(l3 + nxt + vdst + 8192) = sv1; }
        __syncthreads();
    }
    l = swapsum(l);
    scale_rows(o, wsf, 1.0f / l, r32, hi);
    LAS float* X = (LAS float*)(l3 + COMB_OFF) + qblk * (32 * COMB_STRIDE);
    if (map == 1) {
#pragma unroll
        for (int db = 0; db < 4; ++db)
#pragma unroll
            for (int r = 0; r < 16; ++r) X[crow(r, hi) * COMB_STRIDE + 32 * db + r32] = o[db][r];
    }
    __syncthreads();
    if (map == 0) {
#pragma unroll
        for (int db = 0; db < 4; ++db)
#pragma unroll
            for (int r = 0; r < 16; ++r) { const int idx = crow(r, hi) * COMB_STRIDE + 32 * db + r32; X[idx] = o[db][r] - lam * X[idx]; }
        const int q = lane >> 1, half = lane & 1;
        const LAS float* xr = X + q * COMB_STRIDE + half * 4;
        float ss = 0.f;
#pragma unroll
        for (int i = 0; i < 16; ++i) { const f32x4 v = *(LAS const f32x4*)(xr + 8 * i); ss += v[0] * v[0] + v[1] * v[1] + v[2] * v[2] + v[3] * v[3]; }
        ss += __shfl_xor(ss, 1);
        const float rstd = 0.8f / sqrtf(ss * (1.0f / 128.0f) + 1e-5f);
        bf16_t* orow = O + (rowbase + q0 + qblk * 32 + q) * 1024 + h * 128 + half * 4;
#pragma unroll
        for (int i = 0; i < 16; ++i) {
            const f32x4 v = *(LAS const f32x4*)(xr + 8 * i); const f32x4 g4 = *(const f32x4*)(subg + half * 4 + 8 * i);
            u32x2 w; w.x = pk(v[0] * rstd * g4[0], v[1] * rstd * g4[1]); w.y = pk(v[2] * rstd * g4[2], v[3] * rstd * g4[3]);
            *(u32x2*)(orow + 8 * i) = w;
        }
    }
    __syncthreads();
}

constexpr int CQ_OFF = 0, CK_OFF = 65536, CV_OFF = 98304;
__device__ __forceinline__ void cross_unit(LAS unsigned char* l3, const bf16_t* XQ, const bf16_t* MKV, bf16_t* O, int b, int hh, int qb) {
    const int tid = threadIdx.x, lane = tid & 63, r32 = lane & 31, hi = lane >> 5;
    const int wid = __builtin_amdgcn_readfirstlane(tid >> 6), half = wid & 1, qblk = wid >> 1;
    const long rowbase = (long)b * SEQ; const int q0 = qb * 128;
    LAS float* wsf = (LAS float*)(l3 + WSF_OFF) + wid * 32;
    {
        const int row = tid & 127, c0 = tid >> 7;
        const bf16_t* qs = XQ + (rowbase + q0 + row) * 1024 + hh * 256;
#pragma unroll
        for (int i = 0; i < 8; ++i) { const int c = c0 + 4 * i; const u32x4 v = *(const u32x4*)(qs + c * 8); *(LAS u32x4*)(l3 + CQ_OFF + c * 2048 + row * 16) = v; }
    }
    const lds_cptr qp = (lds_cptr)l3 + CQ_OFF + hi * 2048 + (qblk * 32 + r32) * 16;
    const lds_cptr kp = (lds_cptr)l3 + CK_OFF + hi * 1024 + r32 * 16;
    const lds_cptr vp = (lds_cptr)l3 + CV_OFF + half * 16384 + ((lane >> 4) & 1) * 32 + (lane & 3) * 8 + (4 * hi + ((lane & 15) >> 2)) * 64;
    float m = -INFINITY, l = 0.f;
    f32x16 o[4];
#pragma unroll
    for (int db = 0; db < 4; ++db)
#pragma unroll
        for (int r = 0; r < 16; ++r) o[db][r] = 0.f;
    const bf16_t* kvb = MKV + (size_t)(b * MEMLEN) * 2048;
    for (int t = 0; t < MEMLEN / 64; ++t) {
#pragma unroll
        for (int i = 0; i < 4; ++i) {
            const int c = wid + 8 * i;
            const u32x4 kv = *(const u32x4*)(kvb + (size_t)(t * 64 + lane) * 2048 + hh * 256 + c * 8);
            *(LAS u32x4*)(l3 + CK_OFF + c * 1024 + lane * 16) = kv;
            const int blk = wid + 8 * i, key = 16 * (blk & 3) + (lane >> 2), col = (blk >> 2) * 32 + (lane & 3) * 8;
            const u32x4 vv = *(const u32x4*)(kvb + (size_t)(t * 64 + key) * 2048 + 1024 + hh * 256 + col);
            *(LAS u32x4*)(l3 + CV_OFF + blk * 1024 + lane * 16) = vv;
        }
        __syncthreads();
        f32x16 p0, p1;
#pragma unroll
        for (int r = 0; r < 16; ++r) { p0[r] = 0.f; p1[r] = 0.f; }
#pragma unroll
        for (int d0 = 0; d0 < 16; ++d0) {
            const bf16x8 qf = *(LAS const bf16x8*)(qp + d0 * 4096);
            const bf16x8 k0 = *(LAS const bf16x8*)(kp + d0 * 2048), k1 = *(LAS const bf16x8*)(kp + d0 * 2048 + 512);
            p0 = __builtin_amdgcn_mfma_f32_32x32x16_bf16(k0, qf, p0, 0, 0, 0);
            p1 = __builtin_amdgcn_mfma_f32_32x32x16_bf16(k1, qf, p1, 0, 0, 0);
        }
        softmax_pv(p0, p1, m, l, o, wsf, vp, r32, hi);
        __syncthreads();
    }
    l = swapsum(l);
    scale_rows(o, wsf, 1.0f / l, r32, hi);
    bf16_t* ob = O + (rowbase + q0 + qblk * 32) * 1024 + hh * 256 + half * 128 + r32;
#pragma unroll
    for (int db = 0; db < 4; ++db)
#pragma unroll
        for (int r = 0; r < 16; ++r) ob[(size_t)crow(r, hi) * 1024 + 32 * db] = (bf16_t)(pk(o[db][r], 0.f) & 0xffffu);
}

constexpr int SG_V_OFF = 0, SG_ST_OFF = 32768;
__device__ __forceinline__ void sgu_unit(LAS unsigned char* l3, bf16_t* SU, const bf16_t* SV, int chunk, const float* Ws, const float* Bs, const float* gam, const float* bet) {
    const int tid = threadIdx.x, lane = tid & 63, r32 = lane & 31, hi = lane >> 5;
    const int wid = __builtin_amdgcn_readfirstlane(tid >> 6);
    LAS float* st = (LAS float*)(l3 + SG_ST_OFF);
    const size_t R0 = (size_t)chunk * 128;
    for (int rr = 0; rr < 16; ++rr) {
        const int row = wid * 16 + rr;
        const bf16_t* p = SV + (R0 + row) * 1024 + lane * 8;
        const u32x4 a = *(const u32x4*)p, c = *(const u32x4*)(p + 512);
        float v[16] = {bflo(a.x), bfhi(a.x), bflo(a.y), bfhi(a.y), bflo(a.z), bfhi(a.z), bflo(a.w), bfhi(a.w), bflo(c.x), bfhi(c.x), bflo(c.y), bfhi(c.y), bflo(c.z), bfhi(c.z), bflo(c.w), bfhi(c.w)};
        float s = 0.f;
#pragma unroll
        for (int j = 0; j < 16; ++j) s += v[j];
        const float mean = wave_sum(s) * (1.0f / 1024.0f);
        float q = 0.f;
#pragma unroll
        for (int j = 0; j < 16; ++j) { const float d = v[j] - mean; q += d * d; }
        const float rstd = 1.0f / sqrtf(wave_sum(q) * (1.0f / 1024.0f) + 1e-5f);
        if (lane == 0) { st[row * 2] = mean; st[row * 2 + 1] = rstd; }
    }
    __syncthreads();
    const int tb = wid >> 1, dh = wid & 1;
    const lds_cptr vp = (lds_cptr)l3 + SG_V_OFF + ((lane >> 4) & 1) * 32 + (lane & 3) * 8 + (4 * hi + ((lane & 15) >> 2)) * 64;
    for (int g = 0; g < 8; ++g) {
        {
            const int s = tid >> 2, db = tid & 3;
            const float mean = st[s * 2], rstd = st[s * 2 + 1];
            const bf16_t* p = SV + (R0 + s) * 1024 + g * 128 + db * 32;
            const float* gp = gam + g * 128 + db * 32; const float* bp = bet + g * 128 + db * 32;
#pragma unroll
            for (int c = 0; c < 4; ++c) {
                const u32x4 a = *(const u32x4*)(p + c * 8);
                const f32x4 g0 = *(const f32x4*)(gp + c * 8), g1 = *(const f32x4*)(gp + c * 8 + 4), b0 = *(const f32x4*)(bp + c * 8), b1 = *(const f32x4*)(bp + c * 8 + 4);
                u32x4 w;
                w.x = pk((bflo(a.x) - mean) * rstd * g0[0] + b0[0], (bfhi(a.x) - mean) * rstd * g0[1] + b0[1]);
                w.y = pk((bflo(a.y) - mean) * rstd * g0[2] + b0[2], (bfhi(a.y) - mean) * rstd * g0[3] + b0[3]);
                w.z = pk((bflo(a.z) - mean) * rstd * g1[0] + b1[0], (bfhi(a.z) - mean) * rstd * g1[1] + b1[1]);
                w.w = pk((bflo(a.w) - mean) * rstd * g1[2] + b1[2], (bfhi(a.w) - mean) * rstd * g1[3] + b1[3]);
                *(LAS u32x4*)(l3 + SG_V_OFF + (db * 8 + (s >> 4)) * 1024 + (s & 15) * 64 + c * 16) = w;
            }
        }
        __syncthreads();
        f32x16 acc[2];
#pragma unroll
        for (int j = 0; j < 2; ++j)
#pragma unroll
            for (int r = 0; r < 16; ++r) acc[j][r] = 0.f;
        const int trow = 32 * tb + r32;
        const float* wrow = Ws + ((size_t)g * 128 + trow) * 128;
        const int nks = 2 * tb + 2;
        for (int ks = 0; ks < nks; ++ks) {
            const int s0 = 16 * ks + 4 * hi;
            f32x4 wa = *(const f32x4*)(wrow + s0), wb = *(const f32x4*)(wrow + s0 + 8);
#pragma unroll
            for (int j = 0; j < 4; ++j) { if (s0 + j > trow) wa[j] = 0.f; if (s0 + 8 + j > trow) wb[j] = 0.f; }
            u32x4 aw; aw.x = pk(wa[0], wa[1]); aw.y = pk(wa[2], wa[3]); aw.z = pk(wb[0], wb[1]); aw.w = pk(wb[2], wb[3]);
#pragma unroll
            for (int j = 0; j < 2; ++j) {
                const int db = 2 * dh + j;
                const s16x4 lo = vtr(vp + (db * 8 + ks) * 1024), hh = vtr(vp + (db * 8 + ks) * 1024 + 512);
                const bf16x8 vf = (bf16x8){lo[0], lo[1], lo[2], lo[3], hh[0], hh[1], hh[2], hh[3]};
                acc[j] = __builtin_amdgcn_mfma_f32_32x32x16_bf16(__builtin_bit_cast(bf16x8, aw), vf, acc[j], 0, 0, 0);
            }
        }
#pragma unroll
        for (int r = 0; r < 16; ++r) {
            const int tt = 32 * tb + crow(r, hi);
            const float bsv = Bs[g * 128 + tt];
            bf16_t* up = SU + (R0 + tt) * 1024 + g * 128 + 64 * dh + r32;
#pragma unroll
            for (int j = 0; j < 2; ++j) { const float uval = bf2f(up[32 * j]); up[32 * j] = (bf16_t)(pk(uval * (acc[j][r] + bsv), 0.f) & 0xffffu); }
        }
        __syncthreads();
    }
}

__device__ __forceinline__ unsigned pk2(float lo, float hi) { return pk(lo, hi); }
__device__ __forceinline__ void transpose_item(const float* W, int K, int N, bf16_t* WT, int k0, int n0, int out_row0, LAS float* scr, int lane) {
#pragma unroll 8
    for (int i = 0; i < 32; ++i) { const int kk = 2 * i + (lane >> 5); scr[kk * 33 + (lane & 31)] = W[(size_t)(k0 + kk) * N + n0 + (lane & 31)]; }
    asm volatile("s_waitcnt lgkmcnt(0)" ::: "memory");
    const int c = lane & 7;
#pragma unroll
    for (int j = 0; j < 4; ++j) { const int n = (lane >> 3) + 8 * j; const LAS float* s = scr + (8 * c) * 33 + n;
        u32x4 o; o.x = pk2(s[0 * 33], s[1 * 33]); o.y = pk2(s[2 * 33], s[3 * 33]); o.z = pk2(s[4 * 33], s[5 * 33]); o.w = pk2(s[6 * 33], s[7 * 33]);
        *(u32x4*)(WT + (size_t)(out_row0 + n) * K + k0 + 8 * c) = o; }
    asm volatile("s_waitcnt lgkmcnt(0)" ::: "memory");
}
__device__ __forceinline__ void row_to_bf16(const float* xrow, bf16_t* orow, int lane) {
    const f32x4* xr = (const f32x4*)xrow + lane; u32x2* o8 = (u32x2*)orow + lane;
#pragma unroll
    for (int j = 0; j < 4; ++j) { const f32x4 v = xr[64 * j]; u32x2 w; w.x = pk(v[0], v[1]); w.y = pk(v[2], v[3]); o8[64 * j] = w; }
}
__device__ __forceinline__ void ln_row(float* row, const float* g, const float* bta, bf16_t* obf, int lane) {
    f32x4* xr = (f32x4*)row + lane; f32x4 v[4]; float s = 0.f;
#pragma unroll
    for (int j = 0; j < 4; ++j) { v[j] = xr[64 * j]; s += (v[j][0] + v[j][1]) + (v[j][2] + v[j][3]); }
    const float mean = wave_sum(s) * (1.0f / 1024.0f); float q = 0.f;
#pragma unroll
    for (int j = 0; j < 4; ++j) { v[j] = v[j] - mean; q += (v[j][0] * v[j][0] + v[j][1] * v[j][1]) + (v[j][2] * v[j][2] + v[j][3] * v[j][3]); }
    const float rstd = 1.0f / sqrtf(wave_sum(q) * (1.0f / 1024.0f) + 1e-5f);
#pragma unroll
    for (int j = 0; j < 4; ++j) {
        const f32x4 gg = ((const f32x4*)g)[lane + 64 * j], bb = ((const f32x4*)bta)[lane + 64 * j];
        const f32x4 y = v[j] * rstd * gg + bb;
        xr[64 * j] = y;
        if (obf) { u32x2 w; w.x = pk(y[0], y[1]); w.y = pk(y[2], y[3]); ((u32x2*)obf)[lane + 64 * j] = w; }
    }
}
__device__ __forceinline__ void sincos_d(float ang, float& c, float& s) {
    const double a = (double)ang; const double q = rint(a * 0.6366197723675814); const double y = a - q * 1.5707963267948966; const double y2 = y * y;
    const double sp = y * (1.0 + y2 * (-1.0 / 6 + y2 * (1.0 / 120 + y2 * (-1.0 / 5040 + y2 * (1.0 / 362880 + y2 * (-1.0 / 39916800))))));
    const double cp = 1.0 + y2 * (-0.5 + y2 * (1.0 / 24 + y2 * (-1.0 / 720 + y2 * (1.0 / 40320 + y2 * (-1.0 / 3628800 + y2 * (1.0 / 479001600))))));
    const int qi = ((int)q) & 3;
    const double cc = (qi == 0) ? cp : (qi == 1) ? -sp : (qi == 2) ? -cp : sp;
    const double ss = (qi == 0) ? sp : (qi == 1) ? cp : (qi == 2) ? -sp : -cp;
    c = (float)cc; s = (float)ss;
}

#ifndef PH_MASK
#define PH_MASK 0x1ff
#endif
__device__ __forceinline__ const void* karg_ptr(int k) {
    const char* p = (const char*)__builtin_amdgcn_kernarg_segment_ptr(); asm volatile("" : "+s"(p));
    const unsigned long long v = *(const unsigned long long*)(p + 8 * k);
    const unsigned lo = __builtin_amdgcn_readfirstlane((unsigned)v), hi = __builtin_amdgcn_readfirstlane((unsigned)(v >> 32));
    return (const void*)(((unsigned long long)hi << 32) | lo);
}
struct Args { const void* in[24]; float* out; unsigned char* ws; };

__global__ void __launch_bounds__(512, 2) fwd_kernel(Args a) {
    extern __shared__ __attribute__((aligned(16))) unsigned char lds[];
    cg::grid_group grid = cg::this_grid();
    const int tid = threadIdx.x, lane = tid & 63, wave = __builtin_amdgcn_readfirstlane(tid >> 6);
    const int G = gridDim.x, bx = blockIdx.x;
    const int vcu = (G % 8 == 0) ? (bx % 8) * (G / 8) + bx / 8 : bx;
    LAS unsigned char* l3 = (LAS unsigned char*)lds;
#define KARG(k) karg_ptr(k)
#define DECL_WS unsigned char* ws = (unsigned char*)KARG(25); float* out = (float*)KARG(24); (void)ws; (void)out; \
    bf16_t* WT_IN = (bf16_t*)(ws + WS_WIN); bf16_t* WT_MKV = (bf16_t*)(ws + WS_WMKV); bf16_t* WT_BR = (bf16_t*)(ws + WS_WBR); bf16_t* WT_OUT = (bf16_t*)(ws + WS_WOUT); \
    bf16_t* WT_FFI = (bf16_t*)(ws + WS_WFFI); bf16_t* WT_FFO = (bf16_t*)(ws + WS_WFFO); bf16_t* MKV = (bf16_t*)(ws + WS_MKV); bf16_t* MEMB = (bf16_t*)(ws + WS_MEMB); \
    float* ROPE = (float*)(ws + WS_ROPE); \
    bf16_t* XB = (bf16_t*)(ws + 1 * SLOT); bf16_t* QB = (bf16_t*)(ws + 2 * SLOT); bf16_t* KB = (bf16_t*)(ws + 3 * SLOT); bf16_t* VB = (bf16_t*)(ws + 4 * SLOT); \
    bf16_t* SUB = (bf16_t*)(ws + 5 * SLOT); bf16_t* SVB = (bf16_t*)(ws + 6 * SLOT); bf16_t* XQB = (bf16_t*)(ws + 7 * SLOT); \
    bf16_t* ODA = (bf16_t*)out; bf16_t* OXA = (bf16_t*)out + SLOT_ELEMS; \
    bf16_t* GB = QB; bf16_t* MGB = KB; bf16_t* X1B = VB; bf16_t* HB = SUB; \
    (void)WT_IN; (void)WT_MKV; (void)WT_BR; (void)WT_OUT; (void)WT_FFI; (void)WT_FFO; (void)MKV; (void)MEMB; (void)ROPE; (void)XB; (void)QB; (void)KB; (void)VB; (void)SUB; (void)SVB; (void)XQB; \
    (void)ODA; (void)OXA; (void)GB; (void)MGB; (void)X1B; (void)HB;
#if (PH_MASK >> 0) & 1
    {
        DECL_WS
        const float* x = (const float*)KARG(0); const float* mem = (const float*)KARG(1); const int* positions = (const int*)KARG(2); const float* w_in = (const float*)KARG(3);
        const float* w_mkv = (const float*)KARG(13); const float* w_br0 = (const float*)KARG(14); const float* w_br1 = (const float*)KARG(15); const float* w_br2 = (const float*)KARG(16);
        const float* w_out = (const float*)KARG(17); const float* w_ffi = (const float*)KARG(20); const float* w_ffo = (const float*)KARG(21);
        LAS float* scr = (LAS float*)(l3 + wave * 16384);
        const int gw = vcu * 8 + wave, NGW = G * 8;
        constexpr int I_IN = 16 * 288, I_MKV = 16 * 64, I_SQ = 16 * 32, I_FFI = 16 * 176, I_FFO = 44 * 32;
        constexpr int NITEMS = I_IN + I_MKV + 4 * I_SQ + I_FFI + I_FFO;
        for (int it = gw; it < NITEMS; it += NGW) {
            int r = it;
            if (r < I_IN) { const int nb = r % 288, kb = r / 288; transpose_item(w_in, 1024, NIN, WT_IN, kb * 64, nb * 32, nb * 32, scr, lane); continue; } r -= I_IN;
            if (r < I_MKV) { const int nb = r % 64, kb = r / 64; transpose_item(w_mkv, 1024, 2048, WT_MKV, kb * 64, nb * 32, nb * 32, scr, lane); continue; } r -= I_MKV;
            if (r < 3 * I_SQ) { const int w = r / I_SQ, rr = r % I_SQ, nb = rr % 32, kb = rr / 32; transpose_item(w == 0 ? w_br0 : (w == 1 ? w_br1 : w_br2), 1024, 1024, WT_BR + (size_t)w * 1024 * 1024, kb * 64, nb * 32, nb * 32, scr, lane); continue; } r -= 3 * I_SQ;
            if (r < I_SQ) { const int nb = r % 32, kb = r / 32; transpose_item(w_out, 1024, 1024, WT_OUT, kb * 64, nb * 32, nb * 32, scr, lane); continue; } r -= I_SQ;
            if (r < I_FFI) { const int nb = r % 176, kb = r / 176; const int n0 = nb * 32, hf = n0 / DFF, jn = n0 % DFF;
                transpose_item(w_ffi, 1024, 2 * DFF, WT_FFI, kb * 64, n0, 256 * (jn / 128) + 128 * hf + (jn % 128), scr, lane); continue; } r -= I_FFI;
            { const int nb = r % 32, kb = r / 32; transpose_item(w_ffo, DFF, 1024, WT_FFO, kb * 64, nb * 32, nb * 32, scr, lane); }
        }
        for (int m = gw; m < MTOK; m += NGW) row_to_bf16(x + (size_t)m * 1024, XB + (size_t)m * 1024, lane);
        for (int m = gw; m < BATCH * MEMLEN; m += NGW) row_to_bf16(mem + (size_t)m * 1024, MEMB + (size_t)m * 1024, lane);
        for (int idx = (vcu * 512 + tid); idx < MTOK * 8; idx += G * 512) {
            const int row = idx >> 3, i = idx & 7;
            const float invf = (i == 0) ? 1.0f : (i == 1) ? 0.1939227432012558f : (i == 2) ? 0.03760603070259094f : (i == 3) ? 0.007292664609849453f :
                               (i == 4) ? 0.0014142135623842478f : (i == 5) ? 0.00027424818836152554f : (i == 6) ? 5.3182957344688475e-05f : 1.0313385246263351e-05f;
            const float ang = (float)positions[row] * invf; float c, s; sincos_d(ang, c, s);
            ROPE[(size_t)row * 16 + i] = c; ROPE[(size_t)row * 16 + 8 + i] = s;
        }
    }
    grid.sync();
#endif
#if (PH_MASK >> 1) & 1
    {
        DECL_WS
        pg8::Gemm g{XB, WT_IN, MTOK, 6144, 1024}; pg8::StaticOrder S; S.init(MTOK, 6144, G, bx);
        pg8::EpiA E{QB, ROPE};
        pg8::gemm_phase<pg8::EpiA, pg8::StaticOrder, true, true>(l3, g, S, E);
        pg8::Gemm g2{MEMB, WT_MKV, BATCH * MEMLEN, 2048, 1024}; pg8::StaticOrder S2; S2.init(BATCH * MEMLEN, 2048, G, bx);
        pg8::EpiStore<0> E2{MKV, 2048};
        pg8::gemm_phase<pg8::EpiStore<0>, pg8::StaticOrder, true, true>(l3, g2, S2, E2);
    }
    grid.sync();
#endif
#if (PH_MASK >> 2) & 1
    {
        DECL_WS
        const float* lq1 = (const float*)KARG(4); const float* lk1 = (const float*)KARG(5); const float* lq2 = (const float*)KARG(6); const float* lk2 = (const float*)KARG(7);
        const float* subg = (const float*)KARG(8); const float* sg_g = (const float*)KARG(9); const float* sg_b = (const float*)KARG(10); const float* sg_ws = (const float*)KARG(11); const float* sg_bs = (const float*)KARG(12);
        float lam;
        { const float a1 = wave_sum(lq1[lane] * lk1[lane]), a2 = wave_sum(lq2[lane] * lk2[lane]); lam = expf(a1) - expf(a2) + 0.2f; }
        for (int i = 7; i >= 0; --i)
            for (int v = vcu; v < 256; v += G) {
                const int bh = v >> 3, s = v & 7, qb = 16 * (i >> 1) + ((i & 1) ? 15 - s : s);
                diff_unit(l3, QB, KB, VB, ODA, bh >> 3, bh & 7, qb, lam, subg);
            }
        for (int c = vcu; c < 256; c += G) sgu_unit(l3, SUB, SVB, c, sg_ws, sg_bs, sg_g, sg_b);
        for (int i = 0; i < 4; ++i)
            for (int v = vcu; v < 256; v += G) {
                const int c = v * 4 + i, bhh = c >> 6, qb = c & 63;
                cross_unit(l3, XQB, MKV, OXA, bhh >> 2, bhh & 3, qb);
                __syncthreads();
            }
    }
    grid.sync();
#endif
#if (PH_MASK >> 3) & 1
    {
        DECL_WS
#pragma unroll 1
        for (int step = 0; step < 6; ++step) {
            const int b = step >> 1; const bool isg = (step & 1) == 0;
            pg8::StaticOrder S; S.init(MTOK, 1024, G, bx);
            const bf16_t* Ap = isg ? (const bf16_t*)XB : (b == 0 ? (const bf16_t*)ODA : (b == 1 ? (const bf16_t*)SUB : (const bf16_t*)OXA));
            const bf16_t* Bp = isg ? (const bf16_t*)(WT_IN + (size_t)(6144 + 1024 * b) * 1024) : (const bf16_t*)(WT_BR + (size_t)b * 1024 * 1024);
            pg8::Gemm gg{Ap, Bp, MTOK, 1024, 1024};
            pg8::EpiGM Eg{GB, MGB, isg ? 0 : (b == 0 ? 1 : 2)};
            pg8::gemm_phase<pg8::EpiGM, pg8::StaticOrder, true, true>(l3, gg, S, Eg);
        }
    }
    grid.sync();
#endif
#if (PH_MASK >> 4) & 1
    {
        DECL_WS
        const float* x = (const float*)KARG(0);
        pg8::StaticOrder S; S.init(MTOK, 1024, G, bx);
        pg8::Gemm g{MGB, WT_OUT, MTOK, 1024, 1024};
        pg8::EpiRes32 E{x, out, ALPHA_RES};
        pg8::gemm_phase<pg8::EpiRes32, pg8::StaticOrder, true, true>(l3, g, S, E);
    }
    grid.sync();
#endif
#if (PH_MASK >> 5) & 1
    { DECL_WS const float* ln1g = (const float*)KARG(18); const float* ln1b = (const float*)KARG(19);
      const int gw = vcu * 8 + wave, NGW = G * 8; for (int m = gw; m < MTOK; m += NGW) ln_row(out + (size_t)m * 1024, ln1g, ln1b, X1B + (size_t)m * 1024, lane); }
    grid.sync();
#endif
#if (PH_MASK >> 6) & 1
    {
        DECL_WS
        pg8::StaticOrder S; S.init(MTOK, 2 * DFF, G, bx);
        pg8::Gemm g{X1B, WT_FFI, MTOK, 2 * DFF, 1024};
        pg8::EpiSwiglu E{HB};
        pg8::gemm_phase<pg8::EpiSwiglu, pg8::StaticOrder, true, true>(l3, g, S, E);
    }
    grid.sync();
#endif
#if (PH_MASK >> 7) & 1
    {
        DECL_WS
        pg8::StaticOrder S; S.init(MTOK, 1024, G, bx);
        pg8::Gemm g{HB, WT_FFO, MTOK, 1024, DFF};
        pg8::EpiRes32 E{out, out, ALPHA_RES};
        pg8::gemm_phase<pg8::EpiRes32, pg8::StaticOrder, true, true>(l3, g, S, E);
    }
    grid.sync();
#endif
#if (PH_MASK >> 8) & 1
    { DECL_WS const float* ln2g = (const float*)KARG(22); const float* ln2b = (const float*)KARG(23);
      const int gw = vcu * 8 + wave, NGW = G * 8; for (int m = gw; m < MTOK; m += NGW) ln_row(out + (size_t)m * 1024, ln2g, ln2b, nullptr, lane); }
#endif
}

extern "C" void kernel_launch(void* const* d_in, const int* in_sizes, int n_in, void* d_out, int out_size, void* d_ws, size_t ws_size, hipStream_t stream) {
    static int grid = 0;
    if (grid == 0) {
        int dev = 0, cus = 0, per_cu = 0;
        hipGetDevice(&dev);
        hipDeviceGetAttribute(&cus, hipDeviceAttributeMultiprocessorCount, dev);
        hipFuncSetAttribute((const void*)fwd_kernel, hipFuncAttributeMaxDynamicSharedMemorySize, LDS_BYTES);
        hipOccupancyMaxActiveBlocksPerMultiprocessor(&per_cu, (const void*)fwd_kernel, 512, LDS_BYTES);
        (void)hipGetLastError();
        if (per_cu < 1) per_cu = 1;
        grid = cus;
        if (n_in != 24 || ws_size < 8 * SLOT) fprintf(stderr, "kernel_launch: unexpected n_in %d or ws_size %zu\n", n_in, ws_size);
    }
    Args a{};
    for (int i = 0; i < 24; ++i) a.in[i] = d_in[i];
    a.out = (float*)d_out; a.ws = (unsigned char*)d_ws;
    void* args[] = {&a};
    hipError_t e = hipLaunchCooperativeKernel((const void*)fwd_kernel, dim3(grid), dim3(512), args, LDS_BYTES, stream);
    if (e != hipSuccess) fprintf(stderr, "cooperative launch failed: %s (grid %d)\n", hipGetErrorString(e), grid);
}
```

```cpp
#include <hip/hip_runtime.h>
#include <hip/hip_cooperative_groups.h>
#include <cstdio>
#include <cstdint>
namespace cg = cooperative_groups;
namespace pg8 {
#define PG8_LAS __attribute__((address_space(3)))
typedef unsigned short bf16_t;
typedef short bf16x8 __attribute__((ext_vector_type(8)));
typedef float f32x4 __attribute__((ext_vector_type(4)));
typedef unsigned u32x4 __attribute__((ext_vector_type(4)));
constexpr int BM = 256, BK = 64, HALF = 128, HTB = HALF * BK * 2  , STAGE_BYTES = 8 * HTB, NXCD = 8, WGM = 8;

__host__ __device__ __forceinline__ int lds_byte(int r, int c) { const int st = (r >> 4) * 2 + (c >> 5), rr = r & 15, cc = c & 31, ob = rr * 64 + cc * 2; return st * 1024 + (ob ^ (((ob >> 9) & 1) << 5)); }
__host__ __device__ __forceinline__ void stage_rc(int b, int& R, int& C) { const int st = b / 1024, sb = b % 1024, swz = sb ^ (((sb >> 9) & 1) << 5); R = (st >> 1) * 16 + swz / 64; C = (st & 1) * 32 + (swz % 64) / 2; }
__host__ __device__ __forceinline__ int perm32(int rho) { const int n = rho >> 4, i = rho & 15; return 8 * (i >> 2) + 4 * n + (i & 3); }

struct Unit { int pm, pn; };
struct Gemm { const bf16_t* A; const bf16_t* Bt; int M, N, K; };

struct StaticOrder {
    int nM, nN, nwg, G, c;
    __host__ __device__ void init(int M, int N, int G_, int c_) { nM = M / BM; nN = N / BM; nwg = nM * nN; G = G_; c = c_; }
    __host__ __device__ bool next(int i, Unit& u) const {
        const long L = (long)i * G + c; if (L >= nwg) return false;
        int wgid = (int)L; { const int q = nwg / NXCD, r = nwg % NXCD, xcd = wgid % NXCD, off = wgid / NXCD; wgid = (xcd < r ? xcd * (q + 1) : r * (q + 1) + (xcd - r) * q) + off; }
        const int nig = WGM * nN, gid = wgid / nig, fm = gid * WGM, gsz = (nM - fm) < WGM ? (nM - fm) : WGM;
        u.pm = fm + ((wgid % nig) % gsz); u.pn = (wgid % nig) / gsz; return true;
    }
    __device__ __forceinline__ void a_ready(const Unit&) const {}
    __device__ __forceinline__ void done(const Unit&) const {}
};

__device__ __forceinline__ unsigned cvt_pk_bf16(float lo, float hi) { unsigned r; asm volatile("v_cvt_pk_bf16_f32 %0, %1, %2" : "=v"(r) : "v"(lo), "v"(hi)); return r; }
typedef float f32x2 __attribute__((ext_vector_type(2)));
template <class Epi, class Sched, bool ALIGN_EPI = false, bool SP2 = false>
__device__ __forceinline__ void gemm_phase(PG8_LAS unsigned char* lds, const Gemm g, const Sched& S, const Epi& E) {
    int tid_ = threadIdx.x; asm volatile("" : "+v"(tid_));
    const int tid = tid_, wid = __builtin_amdgcn_readfirstlane(tid >> 6), lane = tid & 63, wr = wid >> 2, wc = wid & 3, fr = lane & 15, fq = lane >> 4;
    const int K = g.K, nt = K / BK;
    unsigned voffA[2], voffB[2];
#pragma unroll
    for (int i = 0; i < 2; ++i) { int R, C; stage_rc(tid * 16 + i * 8192, R, C); const int Rb = Epi::PERM ? ((R & ~31) + perm32(R & 31)) : R;
        voffA[i] = (unsigned)(R * K + C) * 2u; voffB[i] = (unsigned)(Rb * K + C) * 2u; }
    const size_t kstep = (size_t)(BK * 2);
    const size_t hstep = (size_t)HALF * K * 2;
    const size_t tstep = 2 * hstep;
    const unsigned ldsw = (unsigned)wid * 1024u;
    const int aoff = lds_byte(wr * 64 + fr, fq * 8), boff = lds_byte(wc * 32 + fr, fq * 8);
#define PG8_SA(b, h) (((b) * 2 + (h)) * HTB)
#define PG8_SB(b, h) ((4 + (b) * 2 + (h)) * HTB)
#define PG8_STAGE(bufoff, gbase, voff) do { _Pragma("unroll") for (int _i = 0; _i < 2; ++_i) \
        __builtin_amdgcn_global_load_lds((const unsigned*)((const char*)(gbase) + (voff)[_i]), (PG8_LAS unsigned*)(lds + (bufoff) + ldsw + _i * 8192), 16, 0, 0); } while (0)
#define PG8_LDA(dst, b, h) do { _Pragma("unroll") for (int m = 0; m < 4; ++m) _Pragma("unroll") for (int k = 0; k < 2; ++k) dst[m][k] = *(const PG8_LAS bf16x8*)(lds + PG8_SA(b, h) + aoff + m * 2048 + k * 1024); } while (0)
#define PG8_LDB(dst, b, h) do { _Pragma("unroll") for (int n = 0; n < 2; ++n) _Pragma("unroll") for (int k = 0; k < 2; ++k) dst[n][k] = *(const PG8_LAS bf16x8*)(lds + PG8_SB(b, h) + boff + n * 2048 + k * 1024); } while (0)
#define PG8_MMA(ai, bj, At, Bt) do { __builtin_amdgcn_s_setprio(1); _Pragma("unroll") for (int m = 0; m < 4; ++m) _Pragma("unroll") for (int n = 0; n < 2; ++n) _Pragma("unroll") for (int k = 0; k < 2; ++k) \
        acc[ai][bj][m][n] = __builtin_amdgcn_mfma_f32_16x16x32_bf16(Bt[n][k], At[m][k], acc[ai][bj][m][n], 0, 0, 0); __builtin_amdgcn_s_setprio(0); } while (0)
#define PG8_WAIT_V(n) asm volatile("s_waitcnt vmcnt(" #n ")" ::: "memory")
#define PG8_WAIT_L(n) asm volatile("s_waitcnt lgkmcnt(" #n ")" ::: "memory")
#define PG8_BAR __builtin_amdgcn_s_barrier()
#define PG8_SCHED __builtin_amdgcn_sched_barrier(0)
    Unit cur, nxt; int ui = 0;
    if (!S.next(0, cur)) return;
    f32x4 acc[2][2][4][2];
#pragma unroll
    for (int a = 0; a < 2; ++a)
#pragma unroll
        for (int b = 0; b < 2; ++b)
#pragma unroll
            for (int m = 0; m < 4; ++m)
#pragma unroll
                for (int n = 0; n < 2; ++n) acc[a][b][m][n] = (f32x4){0.f, 0.f, 0.f, 0.f};
    bf16x8 At[4][2], B0[2][2], B1[2][2];
    const char* cA = (const char*)g.A + (size_t)cur.pm * tstep; const char* cB = (const char*)g.Bt + (size_t)cur.pn * tstep;
    S.a_ready(cur);
    if constexpr (SP2) {
        PG8_STAGE(PG8_SB(0, 0), cB, voffB); PG8_STAGE(PG8_SB(0, 1), cB + hstep, voffB); PG8_STAGE(PG8_SA(0, 0), cA, voffA); PG8_STAGE(PG8_SA(0, 1), cA + hstep, voffA);
        if (wr == 1) PG8_BAR;
        PG8_WAIT_V(2); PG8_BAR;
        PG8_STAGE(PG8_SB(1, 0), cB + kstep, voffB); PG8_STAGE(PG8_SA(1, 0), cA + kstep, voffA); PG8_STAGE(PG8_SB(1, 1), cB + hstep + kstep, voffB);
        PG8_WAIT_V(6); PG8_BAR;
    } else {
        PG8_STAGE(PG8_SB(0, 0), cB, voffB); PG8_STAGE(PG8_SA(0, 0), cA, voffA); PG8_STAGE(PG8_SB(0, 1), cB + hstep, voffB); PG8_STAGE(PG8_SA(0, 1), cA + hstep, voffA);
        if (wr == 1) PG8_BAR;
        PG8_WAIT_V(4); PG8_BAR;
        PG8_STAGE(PG8_SB(1, 0), cB + kstep, voffB); PG8_STAGE(PG8_SA(1, 0), cA + kstep, voffA); PG8_STAGE(PG8_SB(1, 1), cB + hstep + kstep, voffB);
        PG8_WAIT_V(6); PG8_BAR;
    }
    for (;;) {
        const bool has_next = S.next(ui + 1, nxt);
        const char* nA = has_next ? (const char*)g.A + (size_t)nxt.pm * tstep : cA; const char* nB = has_next ? (const char*)g.Bt + (size_t)nxt.pn * tstep : cB;
        for (int t = 0; t < nt; t += 2) {
            const bool last = (t == nt - 2);
            const char* a1 = cA + (size_t)(t + 1) * kstep;
            const char* a2 = last ? nA : cA + (size_t)(t + 2) * kstep; const char* b2 = last ? nB : cB + (size_t)(t + 2) * kstep;
            const char* a3 = a2 + kstep; const char* b3 = b2 + kstep;
            if (last && has_next) S.a_ready(nxt);
            if constexpr (SP2) {
            PG8_LDB(B0, 0, 0); PG8_LDB(B1, 0, 1); PG8_SCHED; PG8_LDA(At, 0, 0); PG8_STAGE(PG8_SA(1, 1), a1 + hstep, voffA);
            PG8_WAIT_V(8); PG8_WAIT_L(0); PG8_BAR; PG8_MMA(0, 0, At, B0); PG8_MMA(0, 1, At, B1); PG8_BAR; PG8_SCHED;
            PG8_LDA(At, 0, 1); PG8_STAGE(PG8_SB(0, 0), b2, voffB); PG8_STAGE(PG8_SB(0, 1), b2 + hstep, voffB); PG8_STAGE(PG8_SA(0, 0), a2, voffA);
            PG8_WAIT_V(8); PG8_WAIT_L(0); PG8_BAR; PG8_MMA(1, 0, At, B0); PG8_MMA(1, 1, At, B1); PG8_BAR; PG8_SCHED;
            PG8_LDB(B0, 1, 0); PG8_LDB(B1, 1, 1); PG8_SCHED; PG8_LDA(At, 1, 0); PG8_STAGE(PG8_SA(0, 1), a2 + hstep, voffA);
            PG8_WAIT_V(8); PG8_WAIT_L(0); PG8_BAR; PG8_MMA(0, 0, At, B0); PG8_MMA(0, 1, At, B1); PG8_BAR; PG8_SCHED;
            PG8_LDA(At, 1, 1); PG8_STAGE(PG8_SB(1, 0), b3, voffB); PG8_STAGE(PG8_SB(1, 1), b3 + hstep, voffB); PG8_STAGE(PG8_SA(1, 0), a3, voffA);
            PG8_WAIT_V(8); PG8_WAIT_L(0); PG8_BAR; PG8_MMA(1, 0, At, B0); PG8_MMA(1, 1, At, B1); PG8_BAR; PG8_SCHED;
            } else {
            PG8_LDB(B0, 0, 0); PG8_SCHED; PG8_LDA(At, 0, 0); PG8_STAGE(PG8_SA(1, 1), a1 + hstep, voffA);
            PG8_WAIT_L(8); PG8_BAR; PG8_WAIT_L(0); PG8_MMA(0, 0, At, B0); PG8_BAR; PG8_SCHED;
            PG8_LDB(B1, 0, 1); PG8_STAGE(PG8_SB(0, 0), b2, voffB);
            PG8_BAR; PG8_WAIT_L(0); PG8_MMA(0, 1, At, B1); PG8_BAR;
            PG8_LDA(At, 0, 1); PG8_STAGE(PG8_SA(0, 0), a2, voffA);
            PG8_BAR; PG8_WAIT_L(0); PG8_MMA(1, 0, At, B0); PG8_BAR; PG8_SCHED;
            PG8_STAGE(PG8_SB(0, 1), b2 + hstep, voffB);
            PG8_WAIT_V(6); PG8_BAR; PG8_MMA(1, 1, At, B1); PG8_BAR;
            PG8_LDB(B0, 1, 0); PG8_SCHED; PG8_LDA(At, 1, 0); PG8_STAGE(PG8_SA(0, 1), a2 + hstep, voffA);
            PG8_WAIT_L(8); PG8_BAR; PG8_WAIT_L(0); PG8_MMA(0, 0, At, B0); PG8_BAR; PG8_SCHED;
            PG8_LDB(B1, 1, 1); PG8_STAGE(PG8_SB(1, 0), b3, voffB);
            PG8_BAR; PG8_WAIT_L(0); PG8_MMA(0, 1, At, B1); PG8_BAR;
            PG8_LDA(At, 1, 1); PG8_STAGE(PG8_SA(1, 0), a3, voffA);
            PG8_BAR; PG8_WAIT_L(0); PG8_MMA(1, 0, At, B0); PG8_BAR; PG8_SCHED;
            PG8_STAGE(PG8_SB(1, 1), b3 + hstep, voffB);
            PG8_WAIT_V(6); PG8_BAR; PG8_MMA(1, 1, At, B1); PG8_BAR;
            }
        }
        if constexpr (ALIGN_EPI) { if (wr == 0) PG8_BAR; }
        if constexpr (!Epi::AFTER_DRAIN) { E(acc, cur, wr, wc, fr, fq); S.done(cur); }
        if (!has_next) break;
#pragma unroll
        for (int a = 0; a < 2; ++a)
#pragma unroll
            for (int b = 0; b < 2; ++b)
#pragma unroll
                for (int m = 0; m < 4; ++m)
#pragma unroll
                    for (int n = 0; n < 2; ++n) acc[a][b][m][n] = (f32x4){0.f, 0.f, 0.f, 0.f};
        cur = nxt; cA = nA; cB = nB; ++ui;
        if constexpr (ALIGN_EPI) { if (wr == 1) PG8_BAR; }
    }
    PG8_WAIT_V(0);
    if constexpr (!ALIGN_EPI) { if (wr == 0) PG8_BAR; }
    PG8_BAR;
    if constexpr (Epi::AFTER_DRAIN) { E.fused(acc, cur, wr, wc, fr, fq, lds, wid, lane); S.done(cur); }
#undef PG8_SA
#undef PG8_SB
#undef PG8_STAGE
#undef PG8_LDA
#undef PG8_LDB
#undef PG8_MMA
#undef PG8_WAIT_V
#undef PG8_WAIT_L
#undef PG8_BAR
#undef PG8_SCHED
}
}

constexpr int BATCH = 4, SEQ = 8192, DM = 1024, MTOK = BATCH * SEQ;
constexpr int MEMLEN = 256, DFF = 2816, NIN = 9216;
constexpr float ALPHA_RES = 1.189207115002721f;
constexpr float LOG2E = 1.4426950408889634f;
constexpr float QSCALE = 0.125f * LOG2E;
constexpr float XQSCALE = 0.0625f * LOG2E;
constexpr size_t MiB = 1u << 20, SLOT = 64 * MiB, SLOT_ELEMS = SLOT / 2;
constexpr size_t WS_WIN = 0, WS_WMKV = 18 * MiB, WS_WBR = 22 * MiB, WS_WOUT = 28 * MiB, WS_WFFI = 30 * MiB, WS_WFFO = 41 * MiB,
                 WS_MKV = 47 * MiB, WS_MEMB = 51 * MiB, WS_ROPE = 53 * MiB, WS_CTL = 56 * MiB, CTL_BYTES = 16384;
constexpr int LDS_BYTES = 147456, LDS_CTL_OFF = 147456 - 64;

typedef unsigned short bf16_t;
typedef short bf16x8 __attribute__((ext_vector_type(8)));
typedef short s16x4 __attribute__((ext_vector_type(4)));
typedef float f32x4 __attribute__((ext_vector_type(4)));
typedef float f32x16 __attribute__((ext_vector_type(16)));
typedef unsigned u32x4 __attribute__((ext_vector_type(4)));
typedef unsigned u32x2 __attribute__((ext_vector_type(2)));
#define LAS __attribute__((address_space(3)))
typedef LAS const char* lds_cptr;

__device__ __forceinline__ float bf2f(unsigned short b) { return __uint_as_float((unsigned)b << 16); }
__device__ __forceinline__ float bflo(unsigned w) { return __uint_as_float(w << 16); }
__device__ __forceinline__ float bfhi(unsigned w) { return __uint_as_float(w & 0xffff0000u); }
__device__ __forceinline__ unsigned pk(float lo, float hi) { return pg8::cvt_pk_bf16(lo, hi); }
__device__ __forceinline__ float fexp2(float x) { return __builtin_amdgcn_exp2f(x); }
__device__ __forceinline__ float frcp(float x) { return __builtin_amdgcn_rcpf(x); }
__device__ __forceinline__ float sigmoid_f(float x) { return frcp(1.0f + fexp2(-LOG2E * x)); }
__device__ __forceinline__ float silu_f(float x) { return x * sigmoid_f(x); }
__device__ __forceinline__ float gelu_tanh_f(float x) {
    const float u = 0.7978845608028654f * (x + 0.044715f * x * x * x);
    return x * frcp(1.0f + fexp2(-2.0f * LOG2E * u));
}
__device__ __forceinline__ float wave_sum(float v) {
#pragma unroll
    for (int o = 1; o < 64; o <<= 1) v += __shfl_xor(v, o);
    return v;
}

namespace pg8 {
struct EpiA {
    static constexpr bool PERM = true, AFTER_DRAIN = false;
    bf16_t* out0; const float* rope;
    __device__ __forceinline__ void operator()(const f32x4 (&acc)[2][2][4][2], const Unit& u, int wr, int wc, int fr, int fq) const {
        const int t = u.pn >> 2;
        bf16_t* base = out0 + (size_t)t * SLOT_ELEMS;
        const int row0 = u.pm * BM + wr * 64 + fr, col0 = (u.pn & 3) * BM + wc * 32 + 8 * fq;
        const bool do_rope = (t <= 1) && ((wc & 1) == 0);
        const float sgn = (fq == 0) ? -1.f : 1.f;
#pragma unroll
        for (int ai = 0; ai < 2; ++ai)
#pragma unroll
            for (int m = 0; m < 4; ++m) {
                const int row = row0 + ai * HALF + m * 16;
                bf16_t* rowp = base + (size_t)row * 1024 + col0;
                f32x4 cs0, cs1, sn0, sn1;
                if (do_rope) { const f32x4* rp = (const f32x4*)(rope + (size_t)row * 16); cs0 = rp[0]; cs1 = rp[1]; sn0 = rp[2]; sn1 = rp[3]; }
#pragma unroll
                for (int bj = 0; bj < 2; ++bj) {
                    f32x4 v0 = acc[ai][bj][m][0], v1 = acc[ai][bj][m][1];
                    if (do_rope) {
                        f32x4 p0, p1;
#pragma unroll
                        for (int j = 0; j < 4; ++j) { p0[j] = __shfl_xor(v0[j], 16); p1[j] = __shfl_xor(v1[j], 16); }
                        if (fq < 2) { v0 = v0 * cs0 + sgn * (p0 * sn0); v1 = v1 * cs1 + sgn * (p1 * sn1); }
                    }
                    if (t == 0) { v0 = v0 * QSCALE; v1 = v1 * QSCALE; }
                    else if (t == 5) { v0 = v0 * XQSCALE; v1 = v1 * XQSCALE; }
                    else if (t == 3 || t == 4) {
#pragma unroll
                        for (int j = 0; j < 4; ++j) { v0[j] = gelu_tanh_f(v0[j]); v1[j] = gelu_tanh_f(v1[j]); }
                    }
                    u32x4 w; w.x = cvt_pk_bf16(v0[0], v0[1]); w.y = cvt_pk_bf16(v0[2], v0[3]); w.z = cvt_pk_bf16(v1[0], v1[1]); w.w = cvt_pk_bf16(v1[2], v1[3]);
                    *(u32x4*)(rowp + bj * HALF) = w;
                }
            }
    }
};
template <int ACT> struct EpiStore {
    static constexpr bool PERM = true, AFTER_DRAIN = false;
    bf16_t* O; int ldc;
    __device__ __forceinline__ void operator()(const f32x4 (&acc)[2][2][4][2], const Unit& u, int wr, int wc, int fr, int fq) const {
        const int row0 = u.pm * BM + wr * 64 + fr, col0 = u.pn * BM + wc * 32 + 8 * fq;
#pragma unroll
        for (int ai = 0; ai < 2; ++ai)
#pragma unroll
            for (int m = 0; m < 4; ++m) {
                bf16_t* rowp = O + (size_t)(row0 + ai * HALF + m * 16) * ldc + col0;
#pragma unroll
                for (int bj = 0; bj < 2; ++bj) {
                    f32x4 v0 = acc[ai][bj][m][0], v1 = acc[ai][bj][m][1];
                    if (ACT == 1) {
#pragma unroll
                        for (int j = 0; j < 4; ++j) { v0[j] = sigmoid_f(v0[j]); v1[j] = sigmoid_f(v1[j]); }
                    }
                    u32x4 w; w.x = cvt_pk_bf16(v0[0], v0[1]); w.y = cvt_pk_bf16(v0[2], v0[3]); w.z = cvt_pk_bf16(v1[0], v1[1]); w.w = cvt_pk_bf16(v1[2], v1[3]);
                    *(u32x4*)(rowp + bj * HALF) = w;
                }
            }
    }
};
struct EpiMerge {
    static constexpr bool PERM = true, AFTER_DRAIN = false;
    const bf16_t* G; bf16_t* MG; int first;
    __device__ __forceinline__ void operator()(const f32x4 (&acc)[2][2][4][2], const Unit& u, int wr, int wc, int fr, int fq) const {
        const int row0 = u.pm * BM + wr * 64 + fr, col0 = u.pn * BM + wc * 32 + 8 * fq;
#pragma unroll
        for (int ai = 0; ai < 2; ++ai)
#pragma unroll
            for (int m = 0; m < 4; ++m) {
                const size_t off = (size_t)(row0 + ai * HALF + m * 16) * 1024 + col0;
#pragma unroll
                for (int bj = 0; bj < 2; ++bj) {
                    const f32x4 v0 = acc[ai][bj][m][0], v1 = acc[ai][bj][m][1];
                    const u32x4 g = *(const u32x4*)(G + off + bj * HALF);
                    float r[8];
                    r[0] = bflo(g.x) * v0[0]; r[1] = bfhi(g.x) * v0[1]; r[2] = bflo(g.y) * v0[2]; r[3] = bfhi(g.y) * v0[3];
                    r[4] = bflo(g.z) * v1[0]; r[5] = bfhi(g.z) * v1[1]; r[6] = bflo(g.w) * v1[2]; r[7] = bfhi(g.w) * v1[3];
                    if (!first) {
                        const u32x4 o = *(const u32x4*)(MG + off + bj * HALF);
                        r[0] += bflo(o.x); r[1] += bfhi(o.x); r[2] += bflo(o.y); r[3] += bfhi(o.y);
                        r[4] += bflo(o.z); r[5] += bfhi(o.z); r[6] += bflo(o.w); r[7] += bfhi(o.w);
                    }
                    u32x4 w; w.x = cvt_pk_bf16(r[0], r[1]); w.y = cvt_pk_bf16(r[2], r[3]); w.z = cvt_pk_bf16(r[4], r[5]); w.w = cvt_pk_bf16(r[6], r[7]);
                    *(u32x4*)(MG + off + bj * HALF) = w;
                }
            }
    }
};
struct EpiGM {
    static constexpr bool PERM = true, AFTER_DRAIN = false;
    bf16_t* G; bf16_t* MG; int mode;
    __device__ __forceinline__ void operator()(const f32x4 (&acc)[2][2][4][2], const Unit& u, int wr, int wc, int fr, int fq) const {
        const int row0 = u.pm * BM + wr * 64 + fr, col0 = u.pn * BM + wc * 32 + 8 * fq;
#pragma unroll
        for (int ai = 0; ai < 2; ++ai)
#pragma unroll
            for (int m = 0; m < 4; ++m) {
                const size_t off = (size_t)(row0 + ai * HALF + m * 16) * 1024 + col0;
#pragma unroll
                for (int bj = 0; bj < 2; ++bj) {
                    const f32x4 v0 = acc[ai][bj][m][0], v1 = acc[ai][bj][m][1];
                    float r[8];
                    if (mode == 0) {
#pragma unroll
                        for (int j = 0; j < 4; ++j) { r[j] = sigmoid_f(v0[j]); r[4 + j] = sigmoid_f(v1[j]); }
                        u32x4 w; w.x = cvt_pk_bf16(r[0], r[1]); w.y = cvt_pk_bf16(r[2], r[3]); w.z = cvt_pk_bf16(r[4], r[5]); w.w = cvt_pk_bf16(r[6], r[7]);
                        *(u32x4*)(G + off + bj * HALF) = w;
                    } else {
                        const u32x4 g = *(const u32x4*)(G + off + bj * HALF);
                        r[0] = bflo(g.x) * v0[0]; r[1] = bfhi(g.x) * v0[1]; r[2] = bflo(g.y) * v0[2]; r[3] = bfhi(g.y) * v0[3];
                        r[4] = bflo(g.z) * v1[0]; r[5] = bfhi(g.z) * v1[1]; r[6] = bflo(g.w) * v1[2]; r[7] = bfhi(g.w) * v1[3];
                        if (mode == 2) {
                            const u32x4 o = *(const u32x4*)(MG + off + bj * HALF);
                            r[0] += bflo(o.x); r[1] += bfhi(o.x); r[2] += bflo(o.y); r[3] += bfhi(o.y);
                            r[4] += bflo(o.z); r[5] += bfhi(o.z); r[6] += bflo(o.w); r[7] += bfhi(o.w);
                        }
                        u32x4 w; w.x = cvt_pk_bf16(r[0], r[1]); w.y = cvt_pk_bf16(r[2], r[3]); w.z = cvt_pk_bf16(r[4], r[5]); w.w = cvt_pk_bf16(r[6], r[7]);
                        *(u32x4*)(MG + off + bj * HALF) = w;
                    }
                }
            }
    }
};
struct EpiRes32 {
    static constexpr bool PERM = true, AFTER_DRAIN = false;
    const float* base; float* out; float alpha;
    __device__ __forceinline__ void operator()(const f32x4 (&acc)[2][2][4][2], const Unit& u, int wr, int wc, int fr, int fq) const {
        const int row0 = u.pm * BM + wr * 64 + fr, col0 = u.pn * BM + wc * 32 + 8 * fq;
#pragma unroll
        for (int ai = 0; ai < 2; ++ai)
#pragma unroll
            for (int m = 0; m < 4; ++m) {
                const size_t off = (size_t)(row0 + ai * HALF + m * 16) * 1024 + col0;
#pragma unroll
                for (int bj = 0; bj < 2; ++bj) {
                    const f32x4 b0 = *(const f32x4*)(base + off + bj * HALF), b1 = *(const f32x4*)(base + off + bj * HALF + 4);
                    const f32x4 o0 = b0 * alpha + acc[ai][bj][m][0], o1 = b1 * alpha + acc[ai][bj][m][1];
                    *(f32x4*)(out + off + bj * HALF) = o0; *(f32x4*)(out + off + bj * HALF + 4) = o1;
                }
            }
    }
};
struct EpiSwiglu {
    static constexpr bool PERM = true, AFTER_DRAIN = false;
    bf16_t* H;
    __device__ __forceinline__ void operator()(const f32x4 (&acc)[2][2][4][2], const Unit& u, int wr, int wc, int fr, int fq) const {
        const int row0 = u.pm * BM + wr * 64 + fr, col0 = u.pn * HALF + wc * 32 + 8 * fq;
#pragma unroll
        for (int ai = 0; ai < 2; ++ai)
#pragma unroll
            for (int m = 0; m < 4; ++m) {
                bf16_t* p = H + (size_t)(row0 + ai * HALF + m * 16) * DFF + col0;
                float r[8];
#pragma unroll
                for (int j = 0; j < 4; ++j) { r[j] = silu_f(acc[ai][0][m][0][j]) * acc[ai][1][m][0][j]; r[4 + j] = silu_f(acc[ai][0][m][1][j]) * acc[ai][1][m][1][j]; }
                u32x4 w; w.x = cvt_pk_bf16(r[0], r[1]); w.y = cvt_pk_bf16(r[2], r[3]); w.z = cvt_pk_bf16(r[4], r[5]); w.w = cvt_pk_bf16(r[6], r[7]);
                *(u32x4*)p = w;
            }
    }
};
}

__device__ __forceinline__ int crow(int r, int hi) { return (r & 3) + 8 * (r >> 2) + 4 * hi; }
typedef short v4i16_t __attribute__((ext_vector_type(4)));
__device__ __forceinline__ s16x4 vtr(lds_cptr p) { return __builtin_bit_cast(s16x4, __builtin_amdgcn_ds_read_tr16_b64_v4i16((LAS v4i16_t*)p)); }
__device__ __forceinline__ float swapmax(float m) {
    auto rr = __builtin_amdgcn_permlane32_swap(__float_as_uint(m), __float_as_uint(m), false, false);
    return fmaxf(__uint_as_float(rr[0]), __uint_as_float(rr[1]));
}
__device__ __forceinline__ float swapsum(float m) {
    auto rr = __builtin_amdgcn_permlane32_swap(__float_as_uint(m), __float_as_uint(m), false, false);
    return __uint_as_float(rr[0]) + __uint_as_float(rr[1]);
}
__device__ __forceinline__ void scale_rows(f32x16 (&o)[4], LAS float* wsf, float fac, int r32, int hi) {
    if (hi == 0) wsf[r32] = fac;
#pragma unroll
    for (int g = 0; g < 4; ++g) {
        const f32x4 a4 = *(LAS const f32x4*)(wsf + 8 * g + 4 * hi);
#pragma unroll
        for (int j = 0; j < 4; ++j)
#pragma unroll
            for (int db = 0; db < 4; ++db) o[db][4 * g + j] *= a4[j];
    }
}
#define SCHED_PIN() __builtin_amdgcn_sched_barrier(0)
__device__ __forceinline__ float max3f(float a, float b, float c) { return __builtin_fmaxf(__builtin_fmaxf(a, b), c); }
__device__ __forceinline__ void softmax_pv(f32x16& p0, f32x16& p1, f32x16& negm, float& l, f32x16 (&o)[4], LAS float* wsf, lds_cptr vp, bool first, int r32, int hi) {
    s16x4 va[8], vb[8];
#define RDV(buf, db) _Pragma("unroll") for (int ks = 0; ks < 4; ++ks) { buf[2 * ks] = vtr(vp + (db) * 4096 + ks * 1024); buf[2 * ks + 1] = vtr(vp + (db) * 4096 + ks * 1024 + 512); }
#define VF(buf, ks) ((bf16x8){buf[2 * (ks)][0], buf[2 * (ks)][1], buf[2 * (ks)][2], buf[2 * (ks)][3], buf[2 * (ks) + 1][0], buf[2 * (ks) + 1][1], buf[2 * (ks) + 1][2], buf[2 * (ks) + 1][3]})
#define PVM(buf, db) _Pragma("unroll") for (int ks = 0; ks < 4; ++ks) o[db] = __builtin_amdgcn_mfma_f32_32x32x16_bf16(__builtin_bit_cast(bf16x8, pw[ks]), VF(buf, ks), o[db], 0, 0, 0);
    RDV(va, 0)
    SCHED_PIN();
    float ra = max3f(p0[0], p0[1], p1[0]), rb = max3f(p0[2], p0[3], p1[1]);
    ra = max3f(ra, p1[2], p1[3]);
#pragma unroll
    for (int r = 4; r < 16; r += 4) { ra = max3f(ra, p0[r], p0[r + 1]); rb = max3f(rb, p0[r + 2], p0[r + 3]); ra = max3f(ra, p1[r], p1[r + 1]); rb = max3f(rb, p1[r + 2], p1[r + 3]); }
    const float rm = swapmax(__builtin_fmaxf(ra, rb));
    if (first) {
#pragma unroll
        for (int r = 0; r < 16; ++r) { p0[r] -= rm; p1[r] -= rm; negm[r] = -rm; }
    } else if (__any(rm > 8.0f)) {
        const float dl = __builtin_fmaxf(rm, 0.f);
#pragma unroll
        for (int r = 0; r < 16; ++r) { p0[r] -= dl; p1[r] -= dl; negm[r] -= dl; }
        const float alpha = fexp2(-dl);
        l *= alpha;
        scale_rows(o, wsf, alpha, r32, hi);
    }
    float s0 = 0.f, s1 = 0.f;
#pragma unroll
    for (int r = 0; r < 16; ++r) { p0[r] = fexp2(p0[r]); p1[r] = fexp2(p1[r]); s0 += p0[r]; s1 += p1[r]; }
    l += s0 + s1;
    u32x4 pw[4];
#pragma unroll
    for (int j = 0; j < 4; ++j) { pw[0][j] = pk(p0[2 * j], p0[2 * j + 1]); pw[1][j] = pk(p0[8 + 2 * j], p0[8 + 2 * j + 1]); pw[2][j] = pk(p1[2 * j], p1[2 * j + 1]); pw[3][j] = pk(p1[8 + 2 * j], p1[8 + 2 * j + 1]); }
    SCHED_PIN();
    RDV(vb, 1)
    SCHED_PIN();
    PVM(va, 0)
    SCHED_PIN();
    RDV(va, 2)
    SCHED_PIN();
    PVM(vb, 1)
    SCHED_PIN();
    RDV(vb, 3)
    SCHED_PIN();
    PVM(va, 2)
    SCHED_PIN();
    PVM(vb, 3)
#undef RDV
#undef VF
#undef PVM
}

constexpr int WSF_OFF = 139264;
constexpr int COMB_OFF = 65536, COMB_STRIDE = 136;

__device__ __forceinline__ void diff_unit(LAS unsigned char* l3, const bf16_t* Q, const bf16_t* K, const bf16_t* V, bf16_t* O, int b, int h, int qb, float lam, const float* subg) {
    int tid = threadIdx.x; asm volatile("" : "+v"(tid));
    const int lane = tid & 63, r32 = lane & 31, hi = lane >> 5;
    const int wid = __builtin_amdgcn_readfirstlane(tid >> 6), map = wid & 1, qblk = wid >> 1;
    const long rowbase = (long)b * SEQ; const int q0 = qb * 128;
    const int NT = (q0 + 128) / 64;
    LAS float* wsf = (LAS float*)(l3 + WSF_OFF) + wid * 32;
    const bf16_t* ksrc = K + (rowbase + lane) * 1024 + h * 128 + wid * 8;
    const bf16_t* vsrc = V + (rowbase + 16 * (wid & 3) + (lane >> 2)) * 1024 + h * 128 + (wid >> 2) * 32 + (lane & 3) * 8;
    const int kdst = wid * 1024 + lane * 16, vdst = 16384 + wid * 1024 + lane * 16;
    const bf16_t* Qw = Q + (rowbase + q0 + qblk * 32 + r32) * 1024 + h * 128 + map * 64;
    bf16x8 qr[4];
#pragma unroll
    for (int d0 = 0; d0 < 4; ++d0) qr[d0] = *(const bf16x8*)(Qw + d0 * 16 + hi * 8);
    const lds_cptr kp = (lds_cptr)l3 + map * 8192 + hi * 1024 + r32 * 16;
    const lds_cptr vp = (lds_cptr)l3 + 16384 + ((lane >> 4) & 1) * 32 + (lane & 3) * 8 + (4 * hi + ((lane & 15) >> 2)) * 64;
    float l = 0.f;
    f32x16 o[4], negm;
#pragma unroll
    for (int r = 0; r < 16; ++r) negm[r] = 0.f;
#pragma unroll
    for (int db = 0; db < 4; ++db)
#pragma unroll
        for (int r = 0; r < 16; ++r) o[db][r] = 0.f;
    u32x4 sk0, sk1, sv0, sv1;
    sk0 = *(const u32x4*)(ksrc); sk1 = *(const u32x4*)(ksrc + 64); sv0 = *(const u32x4*)(vsrc); sv1 = *(const u32x4*)(vsrc + 64);
    *(LAS u32x4*)(l3 + kdst) = sk0; *(LAS u32x4*)(l3 + kdst + 8192) = sk1; *(LAS u32x4*)(l3 + vdst) = sv0; *(LAS u32x4*)(l3 + vdst + 8192) = sv1;
    asm volatile("" :: "v"(qr[0]), "v"(qr[1]), "v"(qr[2]), "v"(qr[3]));
    __syncthreads();
    const int qlast = q0 + qblk * 32 + 31, qg = q0 + qblk * 32 + r32;
    for (int t = 0; t < NT; ++t) {
        const int cur = (t & 1) * 32768, nxt = 32768 - cur;
        const bool more = (t + 1 < NT);
        if (more) { const size_t adv = (size_t)(t + 1) * 64 * 1024;
            sk0 = *(const u32x4*)(ksrc + adv); sk1 = *(const u32x4*)(ksrc + adv + 64); sv0 = *(const u32x4*)(vsrc + adv); sv1 = *(const u32x4*)(vsrc + adv + 64); }
        if (t * 64 <= qlast) {
            f32x16 p0, p1;
            bf16x8 kf[8];
#pragma unroll
            for (int d0 = 0; d0 < 4; ++d0) { kf[2 * d0] = *(LAS const bf16x8*)(kp + cur + d0 * 2048); kf[2 * d0 + 1] = *(LAS const bf16x8*)(kp + cur + d0 * 2048 + 512); }
            SCHED_PIN();
            p0 = __builtin_amdgcn_mfma_f32_32x32x16_bf16(kf[0], qr[0], negm, 0, 0, 0);
            p1 = __builtin_amdgcn_mfma_f32_32x32x16_bf16(kf[1], qr[0], negm, 0, 0, 0);
#pragma unroll
            for (int d0 = 1; d0 < 4; ++d0) {
                p0 = __builtin_amdgcn_mfma_f32_32x32x16_bf16(kf[2 * d0], qr[d0], p0, 0, 0, 0);
                p1 = __builtin_amdgcn_mfma_f32_32x32x16_bf16(kf[2 * d0 + 1], qr[d0], p1, 0, 0, 0);
            }
            if (t >= NT - 2) {
                const int kb = t * 64 + 4 * hi;
#pragma unroll
                for (int r = 0; r < 16; ++r) { const int kv = kb + (r & 3) + 8 * (r >> 2); if (kv > qg) p0[r] = -INFINITY; if (kv + 32 > qg) p1[r] = -INFINITY; }
            }
            softmax_pv(p0, p1, negm, l, o, wsf, vp + cur, t == 0, r32, hi);
        }
        if (more) { *(LAS u32x4*)(l3 + nxt + kdst) = sk0; *(LAS u32x4*)(l3 + nxt + kdst + 8192) = sk1; *(LAS u32x4*)(l3 + nxt + vdst) = sv0; *(LAS u32x4*)(l3 + nxt + vdst + 8192) = sv1; }
        __syncthreads();
    }
    l = swapsum(l);
    scale_rows(o, wsf, 1.0f / l, r32, hi);
    LAS float* X = (LAS float*)(l3 + COMB_OFF) + qblk * (32 * COMB_STRIDE);
    if (map == 1) {
#pragma unroll
        for (int db = 0; db < 4; ++db)
#pragma unroll
            for (int r = 0; r < 16; ++r) X[crow(r, hi) * COMB_STRIDE + 32 * db + r32] = o[db][r];
    }
    __syncthreads();
    if (map == 0) {
#pragma unroll
        for (int db = 0; db < 4; ++db)
#pragma unroll
            for (int r = 0; r < 16; ++r) { const int idx = crow(r, hi) * COMB_STRIDE + 32 * db + r32; X[idx] = o[db][r] - lam * X[idx]; }
        const int q = lane >> 1, half = lane & 1;
        const LAS float* xr = X + q * COMB_STRIDE + half * 4;
        float ss = 0.f;
#pragma unroll
        for (int i = 0; i < 16; ++i) { const f32x4 v = *(LAS const f32x4*)(xr + 8 * i); ss += v[0] * v[0] + v[1] * v[1] + v[2] * v[2] + v[3] * v[3]; }
        ss += __shfl_xor(ss, 1);
        const float rstd = 0.8f / sqrtf(ss * (1.0f / 128.0f) + 1e-5f);
        bf16_t* orow = O + (rowbase + q0 + qblk * 32 + q) * 1024 + h * 128 + half * 4;
#pragma unroll
        for (int i = 0; i < 16; ++i) {
            const f32x4 v = *(LAS const f32x4*)(xr + 8 * i); const f32x4 g4 = *(const f32x4*)(subg + half * 4 + 8 * i);
            u32x2 w; w.x = pk(v[0] * rstd * g4[0], v[1] * rstd * g4[1]); w.y = pk(v[2] * rstd * g4[2], v[3] * rstd * g4[3]);
            *(u32x2*)(orow + 8 * i) = w;
        }
    }
    __syncthreads();
}

constexpr int CQ_OFF = 0, CK_OFF = 65536, CV_OFF = 98304;
__device__ __forceinline__ void cross_unit(LAS unsigned char* l3, const bf16_t* XQ, const bf16_t* MKV, bf16_t* O, int b, int hh, int qb) {
    int tid = threadIdx.x; asm volatile("" : "+v"(tid));
    const int lane = tid & 63, r32 = lane & 31, hi = lane >> 5;
    const int wid = __builtin_amdgcn_readfirstlane(tid >> 6), half = wid & 1, qblk = wid >> 1;
    const long rowbase = (long)b * SEQ; const int q0 = qb * 128;
    LAS float* wsf = (LAS float*)(l3 + WSF_OFF) + wid * 32;
    {
        const int row = tid & 127, c0 = tid >> 7;
        const bf16_t* qs = XQ + (rowbase + q0 + row) * 1024 + hh * 256;
#pragma unroll
        for (int i = 0; i < 8; ++i) { const int c = c0 + 4 * i; const u32x4 v = *(const u32x4*)(qs + c * 8); *(LAS u32x4*)(l3 + CQ_OFF + c * 2048 + row * 16) = v; }
    }
    const lds_cptr qp = (lds_cptr)l3 + CQ_OFF + hi * 2048 + (qblk * 32 + r32) * 16;
    const lds_cptr kp = (lds_cptr)l3 + CK_OFF + hi * 1024 + r32 * 16;
    const lds_cptr vp = (lds_cptr)l3 + CV_OFF + half * 16384 + ((lane >> 4) & 1) * 32 + (lane & 3) * 8 + (4 * hi + ((lane & 15) >> 2)) * 64;
    float l = 0.f;
    f32x16 o[4], negm;
#pragma unroll
    for (int r = 0; r < 16; ++r) negm[r] = 0.f;
#pragma unroll
    for (int db = 0; db < 4; ++db)
#pragma unroll
        for (int r = 0; r < 16; ++r) o[db][r] = 0.f;
    const bf16_t* kvb = MKV + (size_t)(b * MEMLEN) * 2048;
    for (int t = 0; t < MEMLEN / 64; ++t) {
        int lane_t = lane; asm volatile("" : "+v"(lane_t));
#pragma unroll
        for (int i = 0; i < 4; ++i) {
            const int c = wid + 8 * i;
            const u32x4 kv = *(const u32x4*)(kvb + (size_t)(t * 64 + lane_t) * 2048 + hh * 256 + c * 8);
            *(LAS u32x4*)(l3 + CK_OFF + c * 1024 + lane_t * 16) = kv;
            const int blk = wid + 8 * i, key = 16 * (blk & 3) + (lane_t >> 2), col = (blk >> 2) * 32 + (lane_t & 3) * 8;
            const u32x4 vv = *(const u32x4*)(kvb + (size_t)(t * 64 + key) * 2048 + 1024 + hh * 256 + col);
            *(LAS u32x4*)(l3 + CV_OFF + blk * 1024 + lane_t * 16) = vv;
        }
        __syncthreads();
        f32x16 p0, p1;
#pragma unroll
        for (int dg = 0; dg < 4; ++dg) {
            bf16x8 qf[4], k0[4], k1[4];
#pragma unroll
            for (int j = 0; j < 4; ++j) { const int d0 = dg * 4 + j; qf[j] = *(LAS const bf16x8*)(qp + d0 * 4096); k0[j] = *(LAS const bf16x8*)(kp + d0 * 2048); k1[j] = *(LAS const bf16x8*)(kp + d0 * 2048 + 512); }
            SCHED_PIN();
#pragma unroll
            for (int j = 0; j < 4; ++j) {
                if (dg == 0 && j == 0) { p0 = __builtin_amdgcn_mfma_f32_32x32x16_bf16(k0[j], qf[j], negm, 0, 0, 0); p1 = __builtin_amdgcn_mfma_f32_32x32x16_bf16(k1[j], qf[j], negm, 0, 0, 0); }
                else { p0 = __builtin_amdgcn_mfma_f32_32x32x16_bf16(k0[j], qf[j], p0, 0, 0, 0); p1 = __builtin_amdgcn_mfma_f32_32x32x16_bf16(k1[j], qf[j], p1, 0, 0, 0); }
            }
            SCHED_PIN();
        }
        softmax_pv(p0, p1, negm, l, o, wsf, vp, t == 0, r32, hi);
        __syncthreads();
    }
    l = swapsum(l);
    scale_rows(o, wsf, 1.0f / l, r32, hi);
    int r32o = r32; asm volatile("" : "+v"(r32o));
    bf16_t* ob = O + (rowbase + q0 + qblk * 32) * 1024 + hh * 256 + half * 128 + r32o;
#pragma unroll
    for (int db = 0; db < 4; ++db)
#pragma unroll
        for (int r = 0; r < 16; ++r) ob[(size_t)crow(r, hi) * 1024 + 32 * db] = (bf16_t)(pk(o[db][r], 0.f) & 0xffffu);
}

constexpr int SG_V_OFF = 0, SG_ST_OFF = 32768;
__device__ __forceinline__ void sgu_unit(LAS unsigned char* l3, bf16_t* SU, const bf16_t* SV, int chunk, const float* Ws, const float* Bs, const float* gam, const float* bet) {
    int tid = threadIdx.x; asm volatile("" : "+v"(tid));
    const int lane = tid & 63, r32 = lane & 31, hi = lane >> 5;
    const int wid = __builtin_amdgcn_readfirstlane(tid >> 6);
    LAS float* st = (LAS float*)(l3 + SG_ST_OFF);
    const size_t R0 = (size_t)chunk * 128;
    for (int rr = 0; rr < 16; ++rr) {
        const int row = wid * 16 + rr;
        const bf16_t* p = SV + (R0 + row) * 1024 + lane * 8;
        const u32x4 a = *(const u32x4*)p, c = *(const u32x4*)(p + 512);
        float v[16] = {bflo(a.x), bfhi(a.x), bflo(a.y), bfhi(a.y), bflo(a.z), bfhi(a.z), bflo(a.w), bfhi(a.w), bflo(c.x), bfhi(c.x), bflo(c.y), bfhi(c.y), bflo(c.z), bfhi(c.z), bflo(c.w), bfhi(c.w)};
        float s = 0.f;
#pragma unroll
        for (int j = 0; j < 16; ++j) s += v[j];
        const float mean = wave_sum(s) * (1.0f / 1024.0f);
        float q = 0.f;
#pragma unroll
        for (int j = 0; j < 16; ++j) { const float d = v[j] - mean; q += d * d; }
        const float rstd = 1.0f / sqrtf(wave_sum(q) * (1.0f / 1024.0f) + 1e-5f);
        if (lane == 0) { st[row * 2] = mean; st[row * 2 + 1] = rstd; }
    }
    __syncthreads();
    const int tb = wid >> 1, dh = wid & 1;
    const lds_cptr vp = (lds_cptr)l3 + SG_V_OFF + ((lane >> 4) & 1) * 32 + (lane & 3) * 8 + (4 * hi + ((lane & 15) >> 2)) * 64;
    for (int g = 0; g < 8; ++g) {
        {
            const int s = tid >> 2, db = tid & 3;
            const float mean = st[s * 2], rstd = st[s * 2 + 1];
            const bf16_t* p = SV + (R0 + s) * 1024 + g * 128 + db * 32;
            const float* gp = gam + g * 128 + db * 32; const float* bp = bet + g * 128 + db * 32;
#pragma unroll
            for (int c = 0; c < 4; ++c) {
                const u32x4 a = *(const u32x4*)(p + c * 8);
                const f32x4 g0 = *(const f32x4*)(gp + c * 8), g1 = *(const f32x4*)(gp + c * 8 + 4), b0 = *(const f32x4*)(bp + c * 8), b1 = *(const f32x4*)(bp + c * 8 + 4);
                u32x4 w;
                w.x = pk((bflo(a.x) - mean) * rstd * g0[0] + b0[0], (bfhi(a.x) - mean) * rstd * g0[1] + b0[1]);
                w.y = pk((bflo(a.y) - mean) * rstd * g0[2] + b0[2], (bfhi(a.y) - mean) * rstd * g0[3] + b0[3]);
                w.z = pk((bflo(a.z) - mean) * rstd * g1[0] + b1[0], (bfhi(a.z) - mean) * rstd * g1[1] + b1[1]);
                w.w = pk((bflo(a.w) - mean) * rstd * g1[2] + b1[2], (bfhi(a.w) - mean) * rstd * g1[3] + b1[3]);
                *(LAS u32x4*)(l3 + SG_V_OFF + (db * 8 + (s >> 4)) * 1024 + (s & 15) * 64 + c * 16) = w;
            }
        }
        __syncthreads();
        f32x16 acc[2];
#pragma unroll
        for (int j = 0; j < 2; ++j)
#pragma unroll
            for (int r = 0; r < 16; ++r) acc[j][r] = 0.f;
        const int trow = 32 * tb + r32;
        const float* wrow = Ws + ((size_t)g * 128 + trow) * 128;
        const int nks = 2 * tb + 2;
        for (int ks = 0; ks < nks; ++ks) {
            const int s0 = 16 * ks + 4 * hi;
            f32x4 wa = *(const f32x4*)(wrow + s0), wb = *(const f32x4*)(wrow + s0 + 8);
#pragma unroll
            for (int j = 0; j < 4; ++j) { if (s0 + j > trow) wa[j] = 0.f; if (s0 + 8 + j > trow) wb[j] = 0.f; }
            u32x4 aw; aw.x = pk(wa[0], wa[1]); aw.y = pk(wa[2], wa[3]); aw.z = pk(wb[0], wb[1]); aw.w = pk(wb[2], wb[3]);
#pragma unroll
            for (int j = 0; j < 2; ++j) {
                const int db = 2 * dh + j;
                const s16x4 lo = vtr(vp + (db * 8 + ks) * 1024), hh = vtr(vp + (db * 8 + ks) * 1024 + 512);
                const bf16x8 vf = (bf16x8){lo[0], lo[1], lo[2], lo[3], hh[0], hh[1], hh[2], hh[3]};
                acc[j] = __builtin_amdgcn_mfma_f32_32x32x16_bf16(__builtin_bit_cast(bf16x8, aw), vf, acc[j], 0, 0, 0);
            }
        }
#pragma unroll
        for (int r = 0; r < 16; ++r) {
            const int tt = 32 * tb + crow(r, hi);
            const float bsv = Bs[g * 128 + tt];
            bf16_t* up = SU + (R0 + tt) * 1024 + g * 128 + 64 * dh + r32;
#pragma unroll
            for (int j = 0; j < 2; ++j) { const float uval = bf2f(up[32 * j]); up[32 * j] = (bf16_t)(pk(uval * (acc[j][r] + bsv), 0.f) & 0xffffu); }
        }
        __syncthreads();
    }
}

__device__ __forceinline__ unsigned pk2(float lo, float hi) { return pk(lo, hi); }
__device__ __forceinline__ void transpose_item(const float* W, int K, int N, bf16_t* WT, int k0, int n0, int out_row0, LAS float* scr, int lane) {
#pragma unroll 8
    for (int i = 0; i < 32; ++i) { const int kk = 2 * i + (lane >> 5); scr[kk * 33 + (lane & 31)] = W[(size_t)(k0 + kk) * N + n0 + (lane & 31)]; }
    asm volatile("s_waitcnt lgkmcnt(0)" ::: "memory");
    const int c = lane & 7;
#pragma unroll
    for (int j = 0; j < 4; ++j) { const int n = (lane >> 3) + 8 * j; const LAS float* s = scr + (8 * c) * 33 + n;
        u32x4 o; o.x = pk2(s[0 * 33], s[1 * 33]); o.y = pk2(s[2 * 33], s[3 * 33]); o.z = pk2(s[4 * 33], s[5 * 33]); o.w = pk2(s[6 * 33], s[7 * 33]);
        *(u32x4*)(WT + (size_t)(out_row0 + n) * K + k0 + 8 * c) = o; }
    asm volatile("s_waitcnt lgkmcnt(0)" ::: "memory");
}
__device__ __forceinline__ void row_to_bf16(const float* xrow, bf16_t* orow, int lane) {
    const f32x4* xr = (const f32x4*)xrow + lane; u32x2* o8 = (u32x2*)orow + lane;
#pragma unroll
    for (int j = 0; j < 4; ++j) { const f32x4 v = xr[64 * j]; u32x2 w; w.x = pk(v[0], v[1]); w.y = pk(v[2], v[3]); o8[64 * j] = w; }
}
__device__ __forceinline__ void ln_row(float* row, const float* g, const float* bta, bf16_t* obf, int lane) {
    f32x4* xr = (f32x4*)row + lane; f32x4 v[4]; float s = 0.f;
#pragma unroll
    for (int j = 0; j < 4; ++j) { v[j] = xr[64 * j]; s += (v[j][0] + v[j][1]) + (v[j][2] + v[j][3]); }
    const float mean = wave_sum(s) * (1.0f / 1024.0f); float q = 0.f;
#pragma unroll
    for (int j = 0; j < 4; ++j) { v[j] = v[j] - mean; q += (v[j][0] * v[j][0] + v[j][1] * v[j][1]) + (v[j][2] * v[j][2] + v[j][3] * v[j][3]); }
    const float rstd = 1.0f / sqrtf(wave_sum(q) * (1.0f / 1024.0f) + 1e-5f);
#pragma unroll
    for (int j = 0; j < 4; ++j) {
        const f32x4 gg = ((const f32x4*)g)[lane + 64 * j], bb = ((const f32x4*)bta)[lane + 64 * j];
        const f32x4 y = v[j] * rstd * gg + bb;
        xr[64 * j] = y;
        if (obf) { u32x2 w; w.x = pk(y[0], y[1]); w.y = pk(y[2], y[3]); ((u32x2*)obf)[lane + 64 * j] = w; }
    }
}
__device__ __forceinline__ void sincos_d(float ang, float& c, float& s) {
    const double a = (double)ang; const double q = rint(a * 0.6366197723675814); const double y = a - q * 1.5707963267948966; const double y2 = y * y;
    const double sp = y * (1.0 + y2 * (-1.0 / 6 + y2 * (1.0 / 120 + y2 * (-1.0 / 5040 + y2 * (1.0 / 362880 + y2 * (-1.0 / 39916800))))));
    const double cp = 1.0 + y2 * (-0.5 + y2 * (1.0 / 24 + y2 * (-1.0 / 720 + y2 * (1.0 / 40320 + y2 * (-1.0 / 3628800 + y2 * (1.0 / 479001600))))));
    const int qi = ((int)q) & 3;
    const double cc = (qi == 0) ? cp : (qi == 1) ? -sp : (qi == 2) ? -cp : sp;
    const double ss = (qi == 0) ? sp : (qi == 1) ? cp : (qi == 2) ? -sp : -cp;
    c = (float)cc; s = (float)ss;
}

#define XB_TMO      128
#define XB_XCNT(j)  (256  + 64 * (j))
#define XB_XSUB(j)  (1280 + 64 * (j))
#define XB_XGEN(j)  (2304 + 64 * (j))
#define XB_TOP      3328
#define XB_TOPGEN   3392
#define XCD_BAR_WORDS 3456
#define XB_SPIN_CAP (1u << 18)

__device__ __forceinline__ unsigned xb_ld(unsigned* p)              { return __hip_atomic_load(p, __ATOMIC_RELAXED, __HIP_MEMORY_SCOPE_AGENT); }
__device__ __forceinline__ unsigned xb_add(unsigned* p, unsigned v) { return __hip_atomic_fetch_add(p, v, __ATOMIC_RELAXED, __HIP_MEMORY_SCOPE_AGENT); }
__device__ __forceinline__ unsigned xb_xcc_id() { return (unsigned)__builtin_amdgcn_s_getreg((3 << 11) | 20) & 0xFu; }
#define XB_SPIN(cond, bar) do { unsigned _sp = 0; while (cond) { __builtin_amdgcn_s_sleep(1); \
    if ((++_sp & 255u) == 0u) { if (xb_ld(&(bar)[XB_TMO])) break; if (_sp > XB_SPIN_CAP) { atomicAdd(&(bar)[XB_TMO], 1u); break; } } } } while (0)

struct XcdBarrier {
    unsigned* bar; unsigned x;
    volatile LAS unsigned* st;
};

__device__ __forceinline__ XcdBarrier xcd_barrier_post(unsigned* bar, volatile LAS unsigned* st) {
    XcdBarrier b; b.bar = bar; b.x = xb_xcc_id(); b.st = st;
    if (threadIdx.x == 0) (void)xb_add(&bar[XB_XCNT(b.x)], 1u);
    return b;
}
__device__ __forceinline__ void xcd_barrier_complete(unsigned* bar, unsigned x, unsigned& nloc, unsigned& nx) {
    const unsigned G = gridDim.x * gridDim.y * gridDim.z;
    unsigned sum, cnt, mine, sp = 0u;
    for (;;) {
        sum = 0u; cnt = 0u; mine = 0u;
#pragma unroll
        for (unsigned j = 0; j < 16; ++j) { const unsigned c = xb_ld(&bar[XB_XCNT(j)]); sum += c; cnt += (c > 0u) ? 1u : 0u; mine = (j == x) ? c : mine; }
        if (sum == G) break;
        __builtin_amdgcn_s_sleep(1);
        if ((++sp & 255u) == 0u) { if (xb_ld(&bar[XB_TMO])) break; if (sp > XB_SPIN_CAP) { atomicAdd(&bar[XB_TMO], 1u); break; } }
    }
    nloc = mine > 0u ? mine : 1u; nx = cnt > 0u ? cnt : 1u;
}

__device__ __forceinline__ void xcd_barrier(const XcdBarrier& b) {
    asm volatile("s_waitcnt vmcnt(0)" ::: "memory");
    __syncthreads();
    if (threadIdx.x == 0) {
        unsigned* bar = b.bar;
        __builtin_amdgcn_s_waitcnt(0);
        unsigned nloc = b.st[0], nx = b.st[1];
        if (nloc == 0u) { xcd_barrier_complete(bar, b.x, nloc, nx); b.st[0] = nloc; b.st[1] = nx; }
        const unsigned old = xb_add(&bar[XB_XSUB(b.x)], 1u);
        const unsigned gen = old / nloc;
        if (old + 1u == (gen + 1u) * nloc) {
            __builtin_amdgcn_fence(__ATOMIC_RELEASE, "agent");
            asm volatile("s_waitcnt vmcnt(0)" ::: "memory");
            const unsigned og = xb_add(&bar[XB_TOP], 1u);
            const unsigned tg = og / nx;
            if (og + 1u == (tg + 1u) * nx) xb_add(&bar[XB_TOPGEN], 1u);
            else XB_SPIN(xb_ld(&bar[XB_TOPGEN]) == tg, bar);
            __builtin_amdgcn_fence(__ATOMIC_ACQUIRE, "agent");
            xb_add(&bar[XB_XGEN(b.x)], 1u);
            asm volatile("s_waitcnt vmcnt(0)" ::: "memory");
        } else {
            XB_SPIN(xb_ld(&bar[XB_XGEN(b.x)]) == gen, bar);
            __builtin_amdgcn_fence(__ATOMIC_ACQUIRE, "agent");
            asm volatile("s_waitcnt vmcnt(0)" ::: "memory");
        }
    }
    __syncthreads();
}

#ifndef PH_MASK
#define PH_MASK 0x1ff
#endif
__device__ __forceinline__ const void* karg_ptr(int k) {
    const char* p = (const char*)__builtin_amdgcn_kernarg_segment_ptr(); asm volatile("" : "+s"(p));
    const unsigned long long v = *(const unsigned long long*)(p + 8 * k);
    const unsigned lo = __builtin_amdgcn_readfirstlane((unsigned)v), hi = __builtin_amdgcn_readfirstlane((unsigned)(v >> 32));
    typedef __attribute__((address_space(1))) const void* gptr_t;
    return (const void*)(gptr_t)(((unsigned long long)hi << 32) | lo);
}
struct Args { const void* in[24]; float* out; unsigned char* ws; };

#define KARG(k) karg_ptr(k)
__global__ void __launch_bounds__(512, 2) fwd_kernel(Args a) {
    extern __shared__ __attribute__((aligned(16))) unsigned char lds[];
    cg::grid_group grid = cg::this_grid();
    const int tid = threadIdx.x, lane = tid & 63, wave = __builtin_amdgcn_readfirstlane(tid >> 6);
    const int G = gridDim.x, bx = blockIdx.x;
    const int vcu = (G % 8 == 0) ? (bx % 8) * (G / 8) + bx / 8 : bx;
    LAS unsigned char* l3 = (LAS unsigned char*)lds;
    if (tid < 16) ((LAS unsigned*)(l3 + LDS_CTL_OFF))[tid] = 0u;
    __syncthreads();
    XcdBarrier xbar = xcd_barrier_post((unsigned*)((unsigned char*)KARG(25) + WS_CTL), (volatile LAS unsigned*)(l3 + LDS_CTL_OFF));
#define DECL_WS unsigned char* ws = (unsigned char*)KARG(25); float* out = (float*)KARG(24); (void)ws; (void)out; \
    bf16_t* WT_IN = (bf16_t*)(ws + WS_WIN); bf16_t* WT_MKV = (bf16_t*)(ws + WS_WMKV); bf16_t* WT_BR = (bf16_t*)(ws + WS_WBR); bf16_t* WT_OUT = (bf16_t*)(ws + WS_WOUT); \
    bf16_t* WT_FFI = (bf16_t*)(ws + WS_WFFI); bf16_t* WT_FFO = (bf16_t*)(ws + WS_WFFO); bf16_t* MKV = (bf16_t*)(ws + WS_MKV); bf16_t* MEMB = (bf16_t*)(ws + WS_MEMB); \
    float* ROPE = (float*)(ws + WS_ROPE); \
    bf16_t* XB = (bf16_t*)(ws + 1 * SLOT); bf16_t* QB = (bf16_t*)(ws + 2 * SLOT); bf16_t* KB = (bf16_t*)(ws + 3 * SLOT); bf16_t* VB = (bf16_t*)(ws + 4 * SLOT); \
    bf16_t* SUB = (bf16_t*)(ws + 5 * SLOT); bf16_t* SVB = (bf16_t*)(ws + 6 * SLOT); bf16_t* XQB = (bf16_t*)(ws + 7 * SLOT); \
    bf16_t* ODA = (bf16_t*)out; bf16_t* OXA = (bf16_t*)out + SLOT_ELEMS; \
    bf16_t* GB = QB; bf16_t* MGB = KB; bf16_t* X1B = VB; bf16_t* HB = SUB; \
    (void)WT_IN; (void)WT_MKV; (void)WT_BR; (void)WT_OUT; (void)WT_FFI; (void)WT_FFO; (void)MKV; (void)MEMB; (void)ROPE; (void)XB; (void)QB; (void)KB; (void)VB; (void)SUB; (void)SVB; (void)XQB; \
    (void)ODA; (void)OXA; (void)GB; (void)MGB; (void)X1B; (void)HB;
#if (PH_MASK >> 0) & 1
    {
        DECL_WS
        const float* x = (const float*)KARG(0); const float* mem = (const float*)KARG(1); const int* positions = (const int*)KARG(2); const float* w_in = (const float*)KARG(3);
        const float* w_mkv = (const float*)KARG(13); const float* w_br0 = (const float*)KARG(14); const float* w_br1 = (const float*)KARG(15); const float* w_br2 = (const float*)KARG(16);
        const float* w_out = (const float*)KARG(17); const float* w_ffi = (const float*)KARG(20); const float* w_ffo = (const float*)KARG(21);
        LAS float* scr = (LAS float*)(l3 + wave * 16384);
        const int gw = vcu * 8 + wave, NGW = G * 8;
        constexpr int I_IN = 16 * 288, I_MKV = 16 * 64, I_SQ = 16 * 32, I_FFI = 16 * 176, I_FFO = 44 * 32;
        constexpr int NITEMS = I_IN + I_MKV + 4 * I_SQ + I_FFI + I_FFO;
        for (int it = gw; it < NITEMS; it += NGW) {
            int r = it;
            if (r < I_IN) { const int nb = r % 288, kb = r / 288; transpose_item(w_in, 1024, NIN, WT_IN, kb * 64, nb * 32, nb * 32, scr, lane); continue; } r -= I_IN;
            if (r < I_MKV) { const int nb = r % 64, kb = r / 64; transpose_item(w_mkv, 1024, 2048, WT_MKV, kb * 64, nb * 32, nb * 32, scr, lane); continue; } r -= I_MKV;
            if (r < 3 * I_SQ) { const int w = r / I_SQ, rr = r % I_SQ, nb = rr % 32, kb = rr / 32; transpose_item(w == 0 ? w_br0 : (w == 1 ? w_br1 : w_br2), 1024, 1024, WT_BR + (size_t)w * 1024 * 1024, kb * 64, nb * 32, nb * 32, scr, lane); continue; } r -= 3 * I_SQ;
            if (r < I_SQ) { const int nb = r % 32, kb = r / 32; transpose_item(w_out, 1024, 1024, WT_OUT, kb * 64, nb * 32, nb * 32, scr, lane); continue; } r -= I_SQ;
            if (r < I_FFI) { const int nb = r % 176, kb = r / 176; const int n0 = nb * 32, hf = n0 / DFF, jn = n0 % DFF;
                transpose_item(w_ffi, 1024, 2 * DFF, WT_FFI, kb * 64, n0, 256 * (jn / 128) + 128 * hf + (jn % 128), scr, lane); continue; } r -= I_FFI;
            { const int nb = r % 32, kb = r / 32; transpose_item(w_ffo, DFF, 1024, WT_FFO, kb * 64, nb * 32, nb * 32, scr, lane); }
        }
        for (int m = gw; m < MTOK; m += NGW) row_to_bf16(x + (size_t)m * 1024, XB + (size_t)m * 1024, lane);
        for (int m = gw; m < BATCH * MEMLEN; m += NGW) row_to_bf16(mem + (size_t)m * 1024, MEMB + (size_t)m * 1024, lane);
        for (int idx = (vcu * 512 + tid); idx < MTOK * 8; idx += G * 512) {
            const int row = idx >> 3, i = idx & 7;
            const float invf = (i == 0) ? 1.0f : (i == 1) ? 0.1939227432012558f : (i == 2) ? 0.03760603070259094f : (i == 3) ? 0.007292664609849453f :
                               (i == 4) ? 0.0014142135623842478f : (i == 5) ? 0.00027424818836152554f : (i == 6) ? 5.3182957344688475e-05f : 1.0313385246263351e-05f;
            const float ang = (float)positions[row] * invf; float c, s; sincos_d(ang, c, s);
            ROPE[(size_t)row * 16 + i] = c; ROPE[(size_t)row * 16 + 8 + i] = s;
        }
    }
    grid.sync();
#endif
#if (PH_MASK >> 1) & 1
    {
        DECL_WS
        pg8::Gemm g{XB, WT_IN, MTOK, 6144, 1024}; pg8::StaticOrder S; S.init(MTOK, 6144, G, bx);
        pg8::EpiA E{QB, ROPE};
        pg8::gemm_phase<pg8::EpiA, pg8::StaticOrder, true, true>(l3, g, S, E);
        pg8::Gemm g2{MEMB, WT_MKV, BATCH * MEMLEN, 2048, 1024}; pg8::StaticOrder S2; S2.init(BATCH * MEMLEN, 2048, G, bx);
        pg8::EpiStore<0> E2{MKV, 2048};
        pg8::gemm_phase<pg8::EpiStore<0>, pg8::StaticOrder, true, true>(l3, g2, S2, E2);
    }
    xcd_barrier(xbar);
#endif
#if (PH_MASK >> 2) & 1
    {
        DECL_WS
        const float* lq1 = (const float*)KARG(4); const float* lk1 = (const float*)KARG(5); const float* lq2 = (const float*)KARG(6); const float* lk2 = (const float*)KARG(7);
        const float* subg = (const float*)KARG(8); const float* sg_g = (const float*)KARG(9); const float* sg_b = (const float*)KARG(10); const float* sg_ws = (const float*)KARG(11); const float* sg_bs = (const float*)KARG(12);
        float lam;
        { const float a1 = wave_sum(lq1[lane] * lk1[lane]), a2 = wave_sum(lq2[lane] * lk2[lane]); lam = expf(a1) - expf(a2) + 0.2f; }
#ifndef DIFF_REP
#define DIFF_REP 1
#endif
        for (int rep = 0; rep < DIFF_REP; ++rep)
        for (int i = 7; i >= 0; --i)
            for (int v = vcu; v < 256; v += G) {
                const int bh = v >> 3, s = v & 7, qb = 16 * (i >> 1) + ((i & 1) ? 15 - s : s);
                diff_unit(l3, QB, KB, VB, ODA, bh >> 3, bh & 7, qb, lam, subg);
            }
        for (int c = vcu; c < 256; c += G) sgu_unit(l3, SUB, SVB, c, sg_ws, sg_bs, sg_g, sg_b);
#ifndef CROSS_REP
#define CROSS_REP 1
#endif
        for (int rep = 0; rep < CROSS_REP; ++rep)
        for (int i = 0; i < 4; ++i)
            for (int v = vcu; v < 256; v += G) {
                const int c = v * 4 + i, bhh = c >> 6, qb = c & 63;
                cross_unit(l3, XQB, MKV, OXA, bhh >> 2, bhh & 3, qb);
                __syncthreads();
            }
    }
    xcd_barrier(xbar);
#endif
#if (PH_MASK >> 3) & 1
    {
        DECL_WS
#pragma unroll 1
        for (int step = 0; step < 6; ++step) {
            const int b = step >> 1; const bool isg = (step & 1) == 0;
            pg8::StaticOrder S; S.init(MTOK, 1024, G, bx);
            const bf16_t* Ap = isg ? (const bf16_t*)XB : (b == 0 ? (const bf16_t*)ODA : (b == 1 ? (const bf16_t*)SUB : (const bf16_t*)OXA));
            const bf16_t* Bp = isg ? (const bf16_t*)(WT_IN + (size_t)(6144 + 1024 * b) * 1024) : (const bf16_t*)(WT_BR + (size_t)b * 1024 * 1024);
            pg8::Gemm gg{Ap, Bp, MTOK, 1024, 1024};
            pg8::EpiGM Eg{GB, MGB, isg ? 0 : (b == 0 ? 1 : 2)};
            pg8::gemm_phase<pg8::EpiGM, pg8::StaticOrder, true, true>(l3, gg, S, Eg);
        }
    }
    xcd_barrier(xbar);
#endif
#if (PH_MASK >> 4) & 1
    {
        DECL_WS
        const float* x = (const float*)KARG(0);
        pg8::StaticOrder S; S.init(MTOK, 1024, G, bx);
        pg8::Gemm g{MGB, WT_OUT, MTOK, 1024, 1024};
        pg8::EpiRes32 E{x, out, ALPHA_RES};
        pg8::gemm_phase<pg8::EpiRes32, pg8::StaticOrder, true, true>(l3, g, S, E);
    }
    xcd_barrier(xbar);
#endif
#if (PH_MASK >> 5) & 1
    { DECL_WS const float* ln1g = (const float*)KARG(18); const float* ln1b = (const float*)KARG(19);
      const int gw = vcu * 8 + wave, NGW = G * 8; for (int m = gw; m < MTOK; m += NGW) ln_row(out + (size_t)m * 1024, ln1g, ln1b, X1B + (size_t)m * 1024, lane); }
    xcd_barrier(xbar);
#endif
#if (PH_MASK >> 6) & 1
    {
        DECL_WS
        pg8::StaticOrder S; S.init(MTOK, 2 * DFF, G, bx);
        pg8::Gemm g{X1B, WT_FFI, MTOK, 2 * DFF, 1024};
        pg8::EpiSwiglu E{HB};
        pg8::gemm_phase<pg8::EpiSwiglu, pg8::StaticOrder, true, true>(l3, g, S, E);
    }
    xcd_barrier(xbar);
#endif
#if (PH_MASK >> 7) & 1
    {
        DECL_WS
        pg8::StaticOrder S; S.init(MTOK, 1024, G, bx);
        pg8::Gemm g{HB, WT_FFO, MTOK, 1024, DFF};
        pg8::EpiRes32 E{out, out, ALPHA_RES};
        pg8::gemm_phase<pg8::EpiRes32, pg8::StaticOrder, true, true>(l3, g, S, E);
    }
    xcd_barrier(xbar);
#endif
#if (PH_MASK >> 8) & 1
    { DECL_WS const float* ln2g = (const float*)KARG(22); const float* ln2b = (const float*)KARG(23);
      const int gw = vcu * 8 + wave, NGW = G * 8; for (int m = gw; m < MTOK; m += NGW) ln_row(out + (size_t)m * 1024, ln2g, ln2b, nullptr, lane); }
#endif
}

extern "C" void kernel_launch(void* const* d_in, const int* in_sizes, int n_in, void* d_out, int out_size, void* d_ws, size_t ws_size, hipStream_t stream) {
    static int grid = 0;
    if (grid == 0) {
        int dev = 0, cus = 0, per_cu = 0;
        hipGetDevice(&dev);
        hipDeviceGetAttribute(&cus, hipDeviceAttributeMultiprocessorCount, dev);
        hipFuncSetAttribute((const void*)fwd_kernel, hipFuncAttributeMaxDynamicSharedMemorySize, LDS_BYTES);
        hipOccupancyMaxActiveBlocksPerMultiprocessor(&per_cu, (const void*)fwd_kernel, 512, LDS_BYTES);
        (void)hipGetLastError();
        if (per_cu < 1) per_cu = 1;
        grid = cus;
        if (n_in != 24 || ws_size < 8 * SLOT) fprintf(stderr, "kernel_launch: unexpected n_in %d or ws_size %zu\n", n_in, ws_size);
    }
    (void)hipMemsetAsync((unsigned char*)d_ws + WS_CTL, 0, CTL_BYTES, stream);
    Args a{};
    for (int i = 0; i < 24; ++i) a.in[i] = d_in[i];
    a.out = (float*)d_out; a.ws = (unsigned char*)d_ws;
    void* args[] = {&a};
    hipError_t e = hipLaunchCooperativeKernel((const void*)fwd_kernel, dim3(grid), dim3(512), args, LDS_BYTES, stream);
    if (e != hipSuccess) fprintf(stderr, "cooperative launch failed: %s (grid %d)\n", hipGetErrorString(e), grid);
}
```

```cpp
#include <hip/hip_runtime.h>
#include <hip/hip_cooperative_groups.h>
#include <cstdio>
#include <cstdint>
namespace cg = cooperative_groups;
namespace pg8 {
#define PG8_LAS __attribute__((address_space(3)))
typedef unsigned short bf16_t;
typedef short bf16x8 __attribute__((ext_vector_type(8)));
typedef float f32x4 __attribute__((ext_vector_type(4)));
typedef unsigned u32x4 __attribute__((ext_vector_type(4)));
constexpr int BM = 256, BK = 64, HALF = 128, HTB = HALF * BK * 2  , STAGE_BYTES = 8 * HTB, NXCD = 8, WGM = 8;

__host__ __device__ __forceinline__ int lds_byte(int r, int c) { const int st = (r >> 4) * 2 + (c >> 5), rr = r & 15, cc = c & 31, ob = rr * 64 + cc * 2; return st * 1024 + (ob ^ (((ob >> 9) & 1) << 5)); }
__host__ __device__ __forceinline__ void stage_rc(int b, int& R, int& C) { const int st = b / 1024, sb = b % 1024, swz = sb ^ (((sb >> 9) & 1) << 5); R = (st >> 1) * 16 + swz / 64; C = (st & 1) * 32 + (swz % 64) / 2; }
__host__ __device__ __forceinline__ int perm32(int rho) { const int n = rho >> 4, i = rho & 15; return 8 * (i >> 2) + 4 * n + (i & 3); }

struct Unit { int pm, pn; };
struct Gemm { const bf16_t* A; const bf16_t* Bt; int M, N, K; };

struct StaticOrder {
    int nM, nN, nwg, G, c;
    __host__ __device__ void init(int M, int N, int G_, int c_) { nM = M / BM; nN = N / BM; nwg = nM * nN; G = G_; c = c_; }
    __host__ __device__ bool next(int i, Unit& u) const {
        const long L = (long)i * G + c; if (L >= nwg) return false;
        int wgid = (int)L; { const int q = nwg / NXCD, r = nwg % NXCD, xcd = wgid % NXCD, off = wgid / NXCD; wgid = (xcd < r ? xcd * (q + 1) : r * (q + 1) + (xcd - r) * q) + off; }
        const int nig = WGM * nN, gid = wgid / nig, fm = gid * WGM, gsz = (nM - fm) < WGM ? (nM - fm) : WGM;
        u.pm = fm + ((wgid % nig) % gsz); u.pn = (wgid % nig) / gsz; return true;
    }
    __device__ __forceinline__ void a_ready(const Unit&) const {}
    __device__ __forceinline__ void done(const Unit&) const {}
};

__device__ __forceinline__ unsigned cvt_pk_bf16(float lo, float hi) { unsigned r; asm volatile("v_cvt_pk_bf16_f32 %0, %1, %2" : "=v"(r) : "v"(lo), "v"(hi)); return r; }
typedef float f32x2 __attribute__((ext_vector_type(2)));
template <class Epi, class Sched, bool ALIGN_EPI = false, bool SP2 = false>
__device__ __forceinline__ void gemm_phase(PG8_LAS unsigned char* lds, const Gemm g, const Sched& S, const Epi& E) {
    int tid_ = threadIdx.x; asm volatile("" : "+v"(tid_));
    const int tid = tid_, wid = __builtin_amdgcn_readfirstlane(tid >> 6), lane = tid & 63, wr = wid >> 2, wc = wid & 3, fr = lane & 15, fq = lane >> 4;
    const int K = g.K, nt = K / BK;
    unsigned voffA[2], voffB[2];
#pragma unroll
    for (int i = 0; i < 2; ++i) { int R, C; stage_rc(tid * 16 + i * 8192, R, C); const int Rb = Epi::PERM ? ((R & ~31) + perm32(R & 31)) : R;
        voffA[i] = (unsigned)(R * K + C) * 2u; voffB[i] = (unsigned)(Rb * K + C) * 2u; }
    const size_t kstep = (size_t)(BK * 2);
    const size_t hstep = (size_t)HALF * K * 2;
    const size_t tstep = 2 * hstep;
    const unsigned ldsw = (unsigned)wid * 1024u;
    const int aoff = lds_byte(wr * 64 + fr, fq * 8), boff = lds_byte(wc * 32 + fr, fq * 8);
#define PG8_SA(b, h) (((b) * 2 + (h)) * HTB)
#define PG8_SB(b, h) ((4 + (b) * 2 + (h)) * HTB)
#define PG8_STAGE(bufoff, gbase, voff) do { _Pragma("unroll") for (int _i = 0; _i < 2; ++_i) \
        __builtin_amdgcn_global_load_lds((const unsigned*)((const char*)(gbase) + (voff)[_i]), (PG8_LAS unsigned*)(lds + (bufoff) + ldsw + _i * 8192), 16, 0, 0); } while (0)
#define PG8_LDA(dst, b, h) do { _Pragma("unroll") for (int m = 0; m < 4; ++m) _Pragma("unroll") for (int k = 0; k < 2; ++k) dst[m][k] = *(const PG8_LAS bf16x8*)(lds + PG8_SA(b, h) + aoff + m * 2048 + k * 1024); } while (0)
#define PG8_LDB(dst, b, h) do { _Pragma("unroll") for (int n = 0; n < 2; ++n) _Pragma("unroll") for (int k = 0; k < 2; ++k) dst[n][k] = *(const PG8_LAS bf16x8*)(lds + PG8_SB(b, h) + boff + n * 2048 + k * 1024); } while (0)
#define PG8_MMA(ai, bj, At, Bt) do { __builtin_amdgcn_s_setprio(1); _Pragma("unroll") for (int m = 0; m < 4; ++m) _Pragma("unroll") for (int n = 0; n < 2; ++n) _Pragma("unroll") for (int k = 0; k < 2; ++k) \
        acc[ai][bj][m][n] = __builtin_amdgcn_mfma_f32_16x16x32_bf16(Bt[n][k], At[m][k], acc[ai][bj][m][n], 0, 0, 0); __builtin_amdgcn_s_setprio(0); } while (0)
#define PG8_WAIT_V(n) asm volatile("s_waitcnt vmcnt(" #n ")" ::: "memory")
#define PG8_WAIT_L(n) asm volatile("s_waitcnt lgkmcnt(" #n ")" ::: "memory")
#define PG8_BAR __builtin_amdgcn_s_barrier()
#define PG8_SCHED __builtin_amdgcn_sched_barrier(0)
    Unit cur, nxt; int ui = 0;
    if (!S.next(0, cur)) return;
    f32x4 acc[2][2][4][2];
#pragma unroll
    for (int a = 0; a < 2; ++a)
#pragma unroll
        for (int b = 0; b < 2; ++b)
#pragma unroll
            for (int m = 0; m < 4; ++m)
#pragma unroll
                for (int n = 0; n < 2; ++n) acc[a][b][m][n] = (f32x4){0.f, 0.f, 0.f, 0.f};
    bf16x8 At[4][2], B0[2][2], B1[2][2];
    const char* cA = (const char*)g.A + (size_t)cur.pm * tstep; const char* cB = (const char*)g.Bt + (size_t)cur.pn * tstep;
    S.a_ready(cur);
    if constexpr (SP2) {
        PG8_STAGE(PG8_SB(0, 0), cB, voffB); PG8_STAGE(PG8_SB(0, 1), cB + hstep, voffB); PG8_STAGE(PG8_SA(0, 0), cA, voffA); PG8_STAGE(PG8_SA(0, 1), cA + hstep, voffA);
        if (wr == 1) PG8_BAR;
        PG8_WAIT_V(2); PG8_BAR;
        PG8_STAGE(PG8_SB(1, 0), cB + kstep, voffB); PG8_STAGE(PG8_SA(1, 0), cA + kstep, voffA); PG8_STAGE(PG8_SB(1, 1), cB + hstep + kstep, voffB);
        PG8_WAIT_V(6); PG8_BAR;
    } else {
        PG8_STAGE(PG8_SB(0, 0), cB, voffB); PG8_STAGE(PG8_SA(0, 0), cA, voffA); PG8_STAGE(PG8_SB(0, 1), cB + hstep, voffB); PG8_STAGE(PG8_SA(0, 1), cA + hstep, voffA);
        if (wr == 1) PG8_BAR;
        PG8_WAIT_V(4); PG8_BAR;
        PG8_STAGE(PG8_SB(1, 0), cB + kstep, voffB); PG8_STAGE(PG8_SA(1, 0), cA + kstep, voffA); PG8_STAGE(PG8_SB(1, 1), cB + hstep + kstep, voffB);
        PG8_WAIT_V(6); PG8_BAR;
    }
    for (;;) {
        const bool has_next = S.next(ui + 1, nxt);
        const char* nA = has_next ? (const char*)g.A + (size_t)nxt.pm * tstep : cA; const char* nB = has_next ? (const char*)g.Bt + (size_t)nxt.pn * tstep : cB;
        for (int t = 0; t < nt; t += 2) {
            const bool last = (t == nt - 2);
            const char* a1 = cA + (size_t)(t + 1) * kstep;
            const char* a2 = last ? nA : cA + (size_t)(t + 2) * kstep; const char* b2 = last ? nB : cB + (size_t)(t + 2) * kstep;
            const char* a3 = a2 + kstep; const char* b3 = b2 + kstep;
            if (last && has_next) S.a_ready(nxt);
            if constexpr (SP2) {
            PG8_LDB(B0, 0, 0); PG8_LDB(B1, 0, 1); PG8_SCHED; PG8_LDA(At, 0, 0); PG8_STAGE(PG8_SA(1, 1), a1 + hstep, voffA);
            PG8_WAIT_V(8); PG8_WAIT_L(0); PG8_BAR; PG8_MMA(0, 0, At, B0); PG8_MMA(0, 1, At, B1); PG8_BAR; PG8_SCHED;
            PG8_LDA(At, 0, 1); PG8_STAGE(PG8_SB(0, 0), b2, voffB); PG8_STAGE(PG8_SB(0, 1), b2 + hstep, voffB); PG8_STAGE(PG8_SA(0, 0), a2, voffA);
            PG8_WAIT_V(8); PG8_WAIT_L(0); PG8_BAR; PG8_MMA(1, 0, At, B0); PG8_MMA(1, 1, At, B1); PG8_BAR; PG8_SCHED;
            PG8_LDB(B0, 1, 0); PG8_LDB(B1, 1, 1); PG8_SCHED; PG8_LDA(At, 1, 0); PG8_STAGE(PG8_SA(0, 1), a2 + hstep, voffA);
            PG8_WAIT_V(8); PG8_WAIT_L(0); PG8_BAR; PG8_MMA(0, 0, At, B0); PG8_MMA(0, 1, At, B1); PG8_BAR; PG8_SCHED;
            PG8_LDA(At, 1, 1); PG8_STAGE(PG8_SB(1, 0), b3, voffB); PG8_STAGE(PG8_SB(1, 1), b3 + hstep, voffB); PG8_STAGE(PG8_SA(1, 0), a3, voffA);
            PG8_WAIT_V(8); PG8_WAIT_L(0); PG8_BAR; PG8_MMA(1, 0, At, B0); PG8_MMA(1, 1, At, B1); PG8_BAR; PG8_SCHED;
            } else {
            PG8_LDB(B0, 0, 0); PG8_SCHED; PG8_LDA(At, 0, 0); PG8_STAGE(PG8_SA(1, 1), a1 + hstep, voffA);
            PG8_WAIT_L(8); PG8_BAR; PG8_WAIT_L(0); PG8_MMA(0, 0, At, B0); PG8_BAR; PG8_SCHED;
            PG8_LDB(B1, 0, 1); PG8_STAGE(PG8_SB(0, 0), b2, voffB);
            PG8_BAR; PG8_WAIT_L(0); PG8_MMA(0, 1, At, B1); PG8_BAR;
            PG8_LDA(At, 0, 1); PG8_STAGE(PG8_SA(0, 0), a2, voffA);
            PG8_BAR; PG8_WAIT_L(0); PG8_MMA(1, 0, At, B0); PG8_BAR; PG8_SCHED;
            PG8_STAGE(PG8_SB(0, 1), b2 + hstep, voffB);
            PG8_WAIT_V(6); PG8_BAR; PG8_MMA(1, 1, At, B1); PG8_BAR;
            PG8_LDB(B0, 1, 0); PG8_SCHED; PG8_LDA(At, 1, 0); PG8_STAGE(PG8_SA(0, 1), a2 + hstep, voffA);
            PG8_WAIT_L(8); PG8_BAR; PG8_WAIT_L(0); PG8_MMA(0, 0, At, B0); PG8_BAR; PG8_SCHED;
            PG8_LDB(B1, 1, 1); PG8_STAGE(PG8_SB(1, 0), b3, voffB);
            PG8_BAR; PG8_WAIT_L(0); PG8_MMA(0, 1, At, B1); PG8_BAR;
            PG8_LDA(At, 1, 1); PG8_STAGE(PG8_SA(1, 0), a3, voffA);
            PG8_BAR; PG8_WAIT_L(0); PG8_MMA(1, 0, At, B0); PG8_BAR; PG8_SCHED;
            PG8_STAGE(PG8_SB(1, 1), b3 + hstep, voffB);
            PG8_WAIT_V(6); PG8_BAR; PG8_MMA(1, 1, At, B1); PG8_BAR;
            }
        }
        if constexpr (ALIGN_EPI) { if (wr == 0) PG8_BAR; }
        if constexpr (!Epi::AFTER_DRAIN) { E(acc, cur, wr, wc, fr, fq); S.done(cur); }
        if (!has_next) break;
#pragma unroll
        for (int a = 0; a < 2; ++a)
#pragma unroll
            for (int b = 0; b < 2; ++b)
#pragma unroll
                for (int m = 0; m < 4; ++m)
#pragma unroll
                    for (int n = 0; n < 2; ++n) acc[a][b][m][n] = (f32x4){0.f, 0.f, 0.f, 0.f};
        cur = nxt; cA = nA; cB = nB; ++ui;
        if constexpr (ALIGN_EPI) { if (wr == 1) PG8_BAR; }
    }
    PG8_WAIT_V(0);
    if constexpr (!ALIGN_EPI) { if (wr == 0) PG8_BAR; }
    PG8_BAR;
    if constexpr (Epi::AFTER_DRAIN) { E.fused(acc, cur, wr, wc, fr, fq, lds, wid, lane); S.done(cur); }
#undef PG8_SA
#undef PG8_SB
#undef PG8_STAGE
#undef PG8_LDA
#undef PG8_LDB
#undef PG8_MMA
#undef PG8_WAIT_V
#undef PG8_WAIT_L
#undef PG8_BAR
#undef PG8_SCHED
}
}

constexpr int BATCH = 4, SEQ = 8192, DM = 1024, MTOK = BATCH * SEQ;
constexpr int MEMLEN = 256, DFF = 2816, NIN = 9216;
constexpr float ALPHA_RES = 1.189207115002721f;
constexpr float LOG2E = 1.4426950408889634f;
constexpr float QSCALE = 0.125f * LOG2E;
constexpr float XQSCALE = 0.0625f * LOG2E;
constexpr size_t MiB = 1u << 20, SLOT = 64 * MiB, SLOT_ELEMS = SLOT / 2;
constexpr size_t WS_WIN = 0, WS_WMKV = 18 * MiB, WS_WBR = 22 * MiB, WS_WOUT = 28 * MiB, WS_WFFI = 30 * MiB, WS_WFFO = 41 * MiB,
                 WS_MKV = 47 * MiB, WS_MEMB = 51 * MiB, WS_ROPE = 53 * MiB, WS_CTL = 56 * MiB, CTL_BYTES = 16384, WS_WSF = 57 * MiB;
constexpr int LDS_BYTES = 147456, LDS_CTL_OFF = 147456 - 64;

typedef unsigned short bf16_t;
typedef short bf16x8 __attribute__((ext_vector_type(8)));
typedef short s16x4 __attribute__((ext_vector_type(4)));
typedef float f32x4 __attribute__((ext_vector_type(4)));
typedef float f32x16 __attribute__((ext_vector_type(16)));
typedef unsigned u32x4 __attribute__((ext_vector_type(4)));
typedef unsigned u32x2 __attribute__((ext_vector_type(2)));
#define LAS __attribute__((address_space(3)))
typedef LAS const char* lds_cptr;

__device__ __forceinline__ float bf2f(unsigned short b) { return __uint_as_float((unsigned)b << 16); }
__device__ __forceinline__ float bflo(unsigned w) { return __uint_as_float(w << 16); }
__device__ __forceinline__ float bfhi(unsigned w) { return __uint_as_float(w & 0xffff0000u); }
__device__ __forceinline__ unsigned pk(float lo, float hi) { return pg8::cvt_pk_bf16(lo, hi); }
__device__ __forceinline__ float fexp2(float x) { return __builtin_amdgcn_exp2f(x); }
__device__ __forceinline__ float frcp(float x) { return __builtin_amdgcn_rcpf(x); }
__device__ __forceinline__ float sigmoid_f(float x) { return frcp(1.0f + fexp2(-LOG2E * x)); }
__device__ __forceinline__ float silu_f(float x) { return x * sigmoid_f(x); }
__device__ __forceinline__ float gelu_tanh_f(float x) {
    const float u = 0.7978845608028654f * (x + 0.044715f * x * x * x);
    return x * frcp(1.0f + fexp2(-2.0f * LOG2E * u));
}
__device__ __forceinline__ float wave_sum(float v) {
#pragma unroll
    for (int o = 1; o < 64; o <<= 1) v += __shfl_xor(v, o);
    return v;
}

namespace pg8 {
struct EpiA {
    static constexpr bool PERM = true, AFTER_DRAIN = false;
    bf16_t* out0; const float* rope;
    __device__ __forceinline__ void operator()(const f32x4 (&acc)[2][2][4][2], const Unit& u, int wr, int wc, int fr, int fq) const {
        const int t = u.pn >> 2;
        bf16_t* base = out0 + (size_t)t * SLOT_ELEMS;
        const int row0 = u.pm * BM + wr * 64 + fr, col0 = (u.pn & 3) * BM + wc * 32 + 8 * fq;
        const bool do_rope = (t <= 1) && ((wc & 1) == 0);
        const float sgn = (fq == 0) ? -1.f : 1.f;
#pragma unroll
        for (int ai = 0; ai < 2; ++ai)
#pragma unroll
            for (int m = 0; m < 4; ++m) {
                const int row = row0 + ai * HALF + m * 16;
                bf16_t* rowp = base + (size_t)row * 1024 + col0;
                f32x4 cs0, cs1, sn0, sn1;
                if (do_rope) { const f32x4* rp = (const f32x4*)(rope + (size_t)row * 16); cs0 = rp[0]; cs1 = rp[1]; sn0 = rp[2]; sn1 = rp[3]; }
#pragma unroll
                for (int bj = 0; bj < 2; ++bj) {
                    f32x4 v0 = acc[ai][bj][m][0], v1 = acc[ai][bj][m][1];
                    if (do_rope) {
                        f32x4 p0, p1;
#pragma unroll
                        for (int j = 0; j < 4; ++j) { p0[j] = __shfl_xor(v0[j], 16); p1[j] = __shfl_xor(v1[j], 16); }
                        if (fq < 2) { v0 = v0 * cs0 + sgn * (p0 * sn0); v1 = v1 * cs1 + sgn * (p1 * sn1); }
                    }
                    if (t == 0) { v0 = v0 * QSCALE; v1 = v1 * QSCALE; }
                    else if (t == 5) { v0 = v0 * XQSCALE; v1 = v1 * XQSCALE; }
                    else if (t == 3 || t == 4) {
#pragma unroll
                        for (int j = 0; j < 4; ++j) { v0[j] = gelu_tanh_f(v0[j]); v1[j] = gelu_tanh_f(v1[j]); }
                    }
                    u32x4 w; w.x = cvt_pk_bf16(v0[0], v0[1]); w.y = cvt_pk_bf16(v0[2], v0[3]); w.z = cvt_pk_bf16(v1[0], v1[1]); w.w = cvt_pk_bf16(v1[2], v1[3]);
                    *(u32x4*)(rowp + bj * HALF) = w;
                }
            }
    }
};
template <int ACT> struct EpiStore {
    static constexpr bool PERM = true, AFTER_DRAIN = false;
    bf16_t* O; int ldc;
    __device__ __forceinline__ void operator()(const f32x4 (&acc)[2][2][4][2], const Unit& u, int wr, int wc, int fr, int fq) const {
        const int row0 = u.pm * BM + wr * 64 + fr, col0 = u.pn * BM + wc * 32 + 8 * fq;
#pragma unroll
        for (int ai = 0; ai < 2; ++ai)
#pragma unroll
            for (int m = 0; m < 4; ++m) {
                bf16_t* rowp = O + (size_t)(row0 + ai * HALF + m * 16) * ldc + col0;
#pragma unroll
                for (int bj = 0; bj < 2; ++bj) {
                    f32x4 v0 = acc[ai][bj][m][0], v1 = acc[ai][bj][m][1];
                    if (ACT == 1) {
#pragma unroll
                        for (int j = 0; j < 4; ++j) { v0[j] = sigmoid_f(v0[j]); v1[j] = sigmoid_f(v1[j]); }
                    }
                    u32x4 w; w.x = cvt_pk_bf16(v0[0], v0[1]); w.y = cvt_pk_bf16(v0[2], v0[3]); w.z = cvt_pk_bf16(v1[0], v1[1]); w.w = cvt_pk_bf16(v1[2], v1[3]);
                    *(u32x4*)(rowp + bj * HALF) = w;
                }
            }
    }
};
struct EpiMerge {
    static constexpr bool PERM = true, AFTER_DRAIN = false;
    const bf16_t* G; bf16_t* MG; int first;
    __device__ __forceinline__ void operator()(const f32x4 (&acc)[2][2][4][2], const Unit& u, int wr, int wc, int fr, int fq) const {
        const int row0 = u.pm * BM + wr * 64 + fr, col0 = u.pn * BM + wc * 32 + 8 * fq;
#pragma unroll
        for (int ai = 0; ai < 2; ++ai)
#pragma unroll
            for (int m = 0; m < 4; ++m) {
                const size_t off = (size_t)(row0 + ai * HALF + m * 16) * 1024 + col0;
#pragma unroll
                for (int bj = 0; bj < 2; ++bj) {
                    const f32x4 v0 = acc[ai][bj][m][0], v1 = acc[ai][bj][m][1];
                    const u32x4 g = *(const u32x4*)(G + off + bj * HALF);
                    float r[8];
                    r[0] = bflo(g.x) * v0[0]; r[1] = bfhi(g.x) * v0[1]; r[2] = bflo(g.y) * v0[2]; r[3] = bfhi(g.y) * v0[3];
                    r[4] = bflo(g.z) * v1[0]; r[5] = bfhi(g.z) * v1[1]; r[6] = bflo(g.w) * v1[2]; r[7] = bfhi(g.w) * v1[3];
                    if (!first) {
                        const u32x4 o = *(const u32x4*)(MG + off + bj * HALF);
                        r[0] += bflo(o.x); r[1] += bfhi(o.x); r[2] += bflo(o.y); r[3] += bfhi(o.y);
                        r[4] += bflo(o.z); r[5] += bfhi(o.z); r[6] += bflo(o.w); r[7] += bfhi(o.w);
                    }
                    u32x4 w; w.x = cvt_pk_bf16(r[0], r[1]); w.y = cvt_pk_bf16(r[2], r[3]); w.z = cvt_pk_bf16(r[4], r[5]); w.w = cvt_pk_bf16(r[6], r[7]);
                    *(u32x4*)(MG + off + bj * HALF) = w;
                }
            }
    }
};
struct EpiGM {
    static constexpr bool PERM = true, AFTER_DRAIN = false;
    bf16_t* G; bf16_t* MG; int mode;
    __device__ __forceinline__ void operator()(const f32x4 (&acc)[2][2][4][2], const Unit& u, int wr, int wc, int fr, int fq) const {
        const int row0 = u.pm * BM + wr * 64 + fr, col0 = u.pn * BM + wc * 32 + 8 * fq;
#pragma unroll
        for (int ai = 0; ai < 2; ++ai)
#pragma unroll
            for (int m = 0; m < 4; ++m) {
                const size_t off = (size_t)(row0 + ai * HALF + m * 16) * 1024 + col0;
#pragma unroll
                for (int bj = 0; bj < 2; ++bj) {
                    const f32x4 v0 = acc[ai][bj][m][0], v1 = acc[ai][bj][m][1];
                    float r[8];
                    if (mode == 0) {
#pragma unroll
                        for (int j = 0; j < 4; ++j) { r[j] = sigmoid_f(v0[j]); r[4 + j] = sigmoid_f(v1[j]); }
                        u32x4 w; w.x = cvt_pk_bf16(r[0], r[1]); w.y = cvt_pk_bf16(r[2], r[3]); w.z = cvt_pk_bf16(r[4], r[5]); w.w = cvt_pk_bf16(r[6], r[7]);
                        *(u32x4*)(G + off + bj * HALF) = w;
                    } else {
                        const u32x4 g = *(const u32x4*)(G + off + bj * HALF);
                        r[0] = bflo(g.x) * v0[0]; r[1] = bfhi(g.x) * v0[1]; r[2] = bflo(g.y) * v0[2]; r[3] = bfhi(g.y) * v0[3];
                        r[4] = bflo(g.z) * v1[0]; r[5] = bfhi(g.z) * v1[1]; r[6] = bflo(g.w) * v1[2]; r[7] = bfhi(g.w) * v1[3];
                        if (mode == 2) {
                            const u32x4 o = *(const u32x4*)(MG + off + bj * HALF);
                            r[0] += bflo(o.x); r[1] += bfhi(o.x); r[2] += bflo(o.y); r[3] += bfhi(o.y);
                            r[4] += bflo(o.z); r[5] += bfhi(o.z); r[6] += bflo(o.w); r[7] += bfhi(o.w);
                        }
                        u32x4 w; w.x = cvt_pk_bf16(r[0], r[1]); w.y = cvt_pk_bf16(r[2], r[3]); w.z = cvt_pk_bf16(r[4], r[5]); w.w = cvt_pk_bf16(r[6], r[7]);
                        *(u32x4*)(MG + off + bj * HALF) = w;
                    }
                }
            }
    }
};
struct EpiRes32 {
    static constexpr bool PERM = true, AFTER_DRAIN = false;
    const float* base; float* out; float alpha;
    __device__ __forceinline__ void operator()(const f32x4 (&acc)[2][2][4][2], const Unit& u, int wr, int wc, int fr, int fq) const {
        const int row0 = u.pm * BM + wr * 64 + fr, col0 = u.pn * BM + wc * 32 + 8 * fq;
#pragma unroll
        for (int ai = 0; ai < 2; ++ai)
#pragma unroll
            for (int m = 0; m < 4; ++m) {
                const size_t off = (size_t)(row0 + ai * HALF + m * 16) * 1024 + col0;
#pragma unroll
                for (int bj = 0; bj < 2; ++bj) {
                    const f32x4 b0 = *(const f32x4*)(base + off + bj * HALF), b1 = *(const f32x4*)(base + off + bj * HALF + 4);
                    const f32x4 o0 = b0 * alpha + acc[ai][bj][m][0], o1 = b1 * alpha + acc[ai][bj][m][1];
                    *(f32x4*)(out + off + bj * HALF) = o0; *(f32x4*)(out + off + bj * HALF + 4) = o1;
                }
            }
    }
};
struct EpiSwiglu {
    static constexpr bool PERM = true, AFTER_DRAIN = false;
    bf16_t* H;
    __device__ __forceinline__ void operator()(const f32x4 (&acc)[2][2][4][2], const Unit& u, int wr, int wc, int fr, int fq) const {
        const int row0 = u.pm * BM + wr * 64 + fr, col0 = u.pn * HALF + wc * 32 + 8 * fq;
#pragma unroll
        for (int ai = 0; ai < 2; ++ai)
#pragma unroll
            for (int m = 0; m < 4; ++m) {
                bf16_t* p = H + (size_t)(row0 + ai * HALF + m * 16) * DFF + col0;
                float r[8];
#pragma unroll
                for (int j = 0; j < 4; ++j) { r[j] = silu_f(acc[ai][0][m][0][j]) * acc[ai][1][m][0][j]; r[4 + j] = silu_f(acc[ai][0][m][1][j]) * acc[ai][1][m][1][j]; }
                u32x4 w; w.x = cvt_pk_bf16(r[0], r[1]); w.y = cvt_pk_bf16(r[2], r[3]); w.z = cvt_pk_bf16(r[4], r[5]); w.w = cvt_pk_bf16(r[6], r[7]);
                *(u32x4*)p = w;
            }
    }
};
}

__device__ __forceinline__ int crow(int r, int hi) { return (r & 3) + 8 * (r >> 2) + 4 * hi; }
typedef short v4i16_t __attribute__((ext_vector_type(4)));
__device__ __forceinline__ s16x4 vtr(lds_cptr p) { return __builtin_bit_cast(s16x4, __builtin_amdgcn_ds_read_tr16_b64_v4i16((LAS v4i16_t*)p)); }
__device__ __forceinline__ float swapmax(float m) {
    auto rr = __builtin_amdgcn_permlane32_swap(__float_as_uint(m), __float_as_uint(m), false, false);
    return fmaxf(__uint_as_float(rr[0]), __uint_as_float(rr[1]));
}
__device__ __forceinline__ float swapsum(float m) {
    auto rr = __builtin_amdgcn_permlane32_swap(__float_as_uint(m), __float_as_uint(m), false, false);
    return __uint_as_float(rr[0]) + __uint_as_float(rr[1]);
}
__device__ __forceinline__ void scale_rows(f32x16 (&o)[4], LAS float* wsf, float fac, int r32, int hi) {
    if (hi == 0) wsf[r32] = fac;
#pragma unroll
    for (int g = 0; g < 4; ++g) {
        const f32x4 a4 = *(LAS const f32x4*)(wsf + 8 * g + 4 * hi);
#pragma unroll
        for (int j = 0; j < 4; ++j)
#pragma unroll
            for (int db = 0; db < 4; ++db) o[db][4 * g + j] *= a4[j];
    }
}
#define SCHED_PIN() __builtin_amdgcn_sched_barrier(0)
__device__ __forceinline__ float max3f(float a, float b, float c) { return __builtin_fmaxf(__builtin_fmaxf(a, b), c); }
__device__ __forceinline__ void softmax_part(f32x16& p0, f32x16& p1, f32x16& negm, float& l, f32x16 (&o)[4], u32x4 (&pw)[4], LAS float* wsf, bool first, int r32, int hi) {
    float ra = max3f(p0[0], p0[1], p1[0]), rb = max3f(p0[2], p0[3], p1[1]);
    ra = max3f(ra, p1[2], p1[3]);
#pragma unroll
    for (int r = 4; r < 16; r += 4) { ra = max3f(ra, p0[r], p0[r + 1]); rb = max3f(rb, p0[r + 2], p0[r + 3]); ra = max3f(ra, p1[r], p1[r + 1]); rb = max3f(rb, p1[r + 2], p1[r + 3]); }
    const float rm = swapmax(__builtin_fmaxf(ra, rb));
    if (first) {
#pragma unroll
        for (int r = 0; r < 16; ++r) { p0[r] -= rm; p1[r] -= rm; negm[r] = -rm; }
    } else if (__any(rm > 8.0f)) {
        const float dl = __builtin_fmaxf(rm, 0.f);
#pragma unroll
        for (int r = 0; r < 16; ++r) { p0[r] -= dl; p1[r] -= dl; negm[r] -= dl; }
        const float alpha = fexp2(-dl);
        l *= alpha;
        scale_rows(o, wsf, alpha, r32, hi);
    }
    float s0 = 0.f, s1 = 0.f;
#pragma unroll
    for (int r = 0; r < 16; ++r) { p0[r] = fexp2(p0[r]); p1[r] = fexp2(p1[r]); s0 += p0[r]; s1 += p1[r]; }
    l += s0 + s1;
#pragma unroll
    for (int j = 0; j < 4; ++j) { pw[0][j] = pk(p0[2 * j], p0[2 * j + 1]); pw[1][j] = pk(p0[8 + 2 * j], p0[8 + 2 * j + 1]); pw[2][j] = pk(p1[2 * j], p1[2 * j + 1]); pw[3][j] = pk(p1[8 + 2 * j], p1[8 + 2 * j + 1]); }
}
__device__ __forceinline__ void pv_part(const u32x4 (&pw)[4], f32x16 (&o)[4], lds_cptr vp) {
    s16x4 va[8], vb[8];
#define RDV(buf, db) _Pragma("unroll") for (int ks = 0; ks < 4; ++ks) { buf[2 * ks] = vtr(vp + (db) * 4096 + ks * 1024); buf[2 * ks + 1] = vtr(vp + (db) * 4096 + ks * 1024 + 512); }
#define VF(buf, ks) ((bf16x8){buf[2 * (ks)][0], buf[2 * (ks)][1], buf[2 * (ks)][2], buf[2 * (ks)][3], buf[2 * (ks) + 1][0], buf[2 * (ks) + 1][1], buf[2 * (ks) + 1][2], buf[2 * (ks) + 1][3]})
#define PVM(buf, db) _Pragma("unroll") for (int ks = 0; ks < 4; ++ks) o[db] = __builtin_amdgcn_mfma_f32_32x32x16_bf16(__builtin_bit_cast(bf16x8, pw[ks]), VF(buf, ks), o[db], 0, 0, 0);
    SCHED_PIN();
    RDV(va, 0)
    RDV(vb, 1)
    SCHED_PIN();
    PVM(va, 0)
    SCHED_PIN();
    RDV(va, 2)
    SCHED_PIN();
    PVM(vb, 1)
    SCHED_PIN();
    RDV(vb, 3)
    SCHED_PIN();
    PVM(va, 2)
    SCHED_PIN();
    PVM(vb, 3)
    SCHED_PIN();
#undef RDV
#undef VF
#undef PVM
}

constexpr int WSF_OFF = 139264;
constexpr int COMB_OFF = 0, COMB_STRIDE = 136;

constexpr int DK_OFF = 0, DV_OFF = 32768;
__device__ __forceinline__ void diff_unit(LAS unsigned char* l3, const bf16_t* Q, const bf16_t* K, const bf16_t* V, bf16_t* O, int b, int h, int qb, float lam, const float* subg) {
    int tid = threadIdx.x; asm volatile("" : "+v"(tid));
    const int lane = tid & 63, r32 = lane & 31, hi = lane >> 5;
    const int wid = __builtin_amdgcn_readfirstlane(tid >> 6), map = wid & 1, qblk = wid >> 1;
    const bool late = wid >= 4;
    const long rowbase = (long)b * SEQ; const int q0 = qb * 128;
    const int NT = (q0 + 128) / 64;
    LAS float* wsf = (LAS float*)(l3 + WSF_OFF) + wid * 32;
    const bf16_t* ksrc = K + (rowbase + lane) * 1024 + h * 128 + wid * 8;
    const bf16_t* vsrc = V + (rowbase + 16 * (wid & 3) + (lane >> 2)) * 1024 + h * 128 + (wid >> 2) * 32 + (lane & 3) * 8;
    const int kdst = DK_OFF + wid * 1024 + lane * 16, vdst = DV_OFF + wid * 1024 + lane * 16;
    const bf16_t* Qw = Q + (rowbase + q0 + qblk * 32 + r32) * 1024 + h * 128 + map * 64;
    bf16x8 qr[4];
#pragma unroll
    for (int d0 = 0; d0 < 4; ++d0) qr[d0] = *(const bf16x8*)(Qw + d0 * 16 + hi * 8);
    const lds_cptr kp = (lds_cptr)l3 + DK_OFF + map * 8192 + hi * 1024 + r32 * 16;
    const lds_cptr vp = (lds_cptr)l3 + DV_OFF + ((lane >> 4) & 1) * 32 + (lane & 3) * 8 + (4 * hi + ((lane & 15) >> 2)) * 64;
    float l = 0.f;
    f32x16 o[4], negm;
#pragma unroll
    for (int r = 0; r < 16; ++r) negm[r] = 0.f;
#pragma unroll
    for (int db = 0; db < 4; ++db)
#pragma unroll
        for (int r = 0; r < 16; ++r) o[db][r] = 0.f;
    u32x4 sk0, sk1, sv0, sv1;
    sk0 = *(const u32x4*)(ksrc); sk1 = *(const u32x4*)(ksrc + 64); sv0 = *(const u32x4*)(vsrc); sv1 = *(const u32x4*)(vsrc + 64);
    *(LAS u32x4*)(l3 + kdst) = sk0; *(LAS u32x4*)(l3 + kdst + 8192) = sk1; *(LAS u32x4*)(l3 + vdst) = sv0; *(LAS u32x4*)(l3 + vdst + 8192) = sv1;
    asm volatile("" :: "v"(qr[0]), "v"(qr[1]), "v"(qr[2]), "v"(qr[3]));
    __syncthreads();
    const int qlast = q0 + qblk * 32 + 31, qg = q0 + qblk * 32 + r32;
    u32x4 pw[4];
    int vcur = 0;
    for (int t = 0; t < NT; ++t) {
        const int kcur = (t & 1) * 16384, knxt = 16384 - kcur;
        const int vprev = (vcur == 0) ? 32768 : vcur - 16384, vnxt = (vcur == 32768) ? 0 : vcur + 16384;
        const bool more = (t + 1 < NT);
        if (more) { const size_t adv = (size_t)(t + 1) * 64 * 1024;
            sk0 = *(const u32x4*)(ksrc + adv); sk1 = *(const u32x4*)(ksrc + adv + 64); sv0 = *(const u32x4*)(vsrc + adv); sv1 = *(const u32x4*)(vsrc + adv + 64); }
        if (late && t > 0) pv_part(pw, o, vp + vprev);
        if (t * 64 <= qlast) {
            f32x16 p0, p1;
            bf16x8 kf[8];
#pragma unroll
            for (int d0 = 0; d0 < 4; ++d0) { kf[2 * d0] = *(LAS const bf16x8*)(kp + kcur + d0 * 2048); kf[2 * d0 + 1] = *(LAS const bf16x8*)(kp + kcur + d0 * 2048 + 512); }
            SCHED_PIN();
            p0 = __builtin_amdgcn_mfma_f32_32x32x16_bf16(kf[0], qr[0], negm, 0, 0, 0);
            p1 = __builtin_amdgcn_mfma_f32_32x32x16_bf16(kf[1], qr[0], negm, 0, 0, 0);
#pragma unroll
            for (int d0 = 1; d0 < 4; ++d0) {
                p0 = __builtin_amdgcn_mfma_f32_32x32x16_bf16(kf[2 * d0], qr[d0], p0, 0, 0, 0);
                p1 = __builtin_amdgcn_mfma_f32_32x32x16_bf16(kf[2 * d0 + 1], qr[d0], p1, 0, 0, 0);
            }
            if (t >= NT - 2) {
                const int kb = t * 64 + 4 * hi;
#pragma unroll
                for (int r = 0; r < 16; ++r) { const int kv = kb + (r & 3) + 8 * (r >> 2); if (kv > qg) p0[r] = -INFINITY; if (kv + 32 > qg) p1[r] = -INFINITY; }
            }
            softmax_part(p0, p1, negm, l, o, pw, wsf, t == 0, r32, hi);
            if (!late) pv_part(pw, o, vp + vcur);
        }
        if (more) { *(LAS u32x4*)(l3 + knxt + kdst) = sk0; *(LAS u32x4*)(l3 + knxt + kdst + 8192) = sk1; *(LAS u32x4*)(l3 + vnxt + vdst) = sv0; *(LAS u32x4*)(l3 + vnxt + vdst + 8192) = sv1; }
        __syncthreads();
        vcur = vnxt;
    }
    if (late) { const int vlast = (vcur == 0) ? 32768 : vcur - 16384; pv_part(pw, o, vp + vlast); }
    l = swapsum(l);
    scale_rows(o, wsf, 1.0f / l, r32, hi);
    __syncthreads();
    LAS float* X = (LAS float*)(l3 + COMB_OFF) + qblk * (32 * COMB_STRIDE);
    if (map == 1) {
#pragma unroll
        for (int db = 0; db < 4; ++db)
#pragma unroll
            for (int r = 0; r < 16; ++r) X[crow(r, hi) * COMB_STRIDE + 32 * db + r32] = o[db][r];
    }
    __syncthreads();
    if (map == 0) {
#pragma unroll
        for (int db = 0; db < 4; ++db)
#pragma unroll
            for (int r = 0; r < 16; ++r) { const int idx = crow(r, hi) * COMB_STRIDE + 32 * db + r32; X[idx] = o[db][r] - lam * X[idx]; }
        const int q = lane >> 1, half = lane & 1;
        const LAS float* xr = X + q * COMB_STRIDE + half * 4;
        float ss = 0.f;
#pragma unroll
        for (int i = 0; i < 16; ++i) { const f32x4 v = *(LAS const f32x4*)(xr + 8 * i); ss += v[0] * v[0] + v[1] * v[1] + v[2] * v[2] + v[3] * v[3]; }
        ss += __shfl_xor(ss, 1);
        const float rstd = 0.8f / sqrtf(ss * (1.0f / 128.0f) + 1e-5f);
        bf16_t* orow = O + (rowbase + q0 + qblk * 32 + q) * 1024 + h * 128 + half * 4;
#pragma unroll
        for (int i = 0; i < 16; ++i) {
            const f32x4 v = *(LAS const f32x4*)(xr + 8 * i); const f32x4 g4 = *(const f32x4*)(subg + half * 4 + 8 * i);
            u32x2 w; w.x = pk(v[0] * rstd * g4[0], v[1] * rstd * g4[1]); w.y = pk(v[2] * rstd * g4[2], v[3] * rstd * g4[3]);
            *(u32x2*)(orow + 8 * i) = w;
        }
    }
    __syncthreads();
}

constexpr int CQ_OFF = 0, CK_OFF = 65536, CV_OFF = 98304;
__device__ __forceinline__ void cross_unit(LAS unsigned char* l3, const bf16_t* XQ, const bf16_t* MKV, bf16_t* O, int b, int hh, int qb) {
    int tid = threadIdx.x; asm volatile("" : "+v"(tid));
    const int lane = tid & 63, r32 = lane & 31, hi = lane >> 5;
    const int wid = __builtin_amdgcn_readfirstlane(tid >> 6), half = wid & 1, qblk = wid >> 1;
    const long rowbase = (long)b * SEQ; const int q0 = qb * 128;
    LAS float* wsf = (LAS float*)(l3 + WSF_OFF) + wid * 32;
    {
        const int row = tid & 127, c0 = tid >> 7;
        const bf16_t* qs = XQ + (rowbase + q0 + row) * 1024 + hh * 256;
#pragma unroll
        for (int i = 0; i < 8; ++i) { const int c = c0 + 4 * i; const u32x4 v = *(const u32x4*)(qs + c * 8); *(LAS u32x4*)(l3 + CQ_OFF + c * 2048 + row * 16) = v; }
    }
    const lds_cptr qp = (lds_cptr)l3 + CQ_OFF + hi * 2048 + (qblk * 32 + r32) * 16;
    const lds_cptr kp = (lds_cptr)l3 + CK_OFF + hi * 1024 + r32 * 16;
    const lds_cptr vp = (lds_cptr)l3 + CV_OFF + half * 16384 + ((lane >> 4) & 1) * 32 + (lane & 3) * 8 + (4 * hi + ((lane & 15) >> 2)) * 64;
    float l = 0.f;
    f32x16 o[4], negm;
#pragma unroll
    for (int r = 0; r < 16; ++r) negm[r] = 0.f;
#pragma unroll
    for (int db = 0; db < 4; ++db)
#pragma unroll
        for (int r = 0; r < 16; ++r) o[db][r] = 0.f;
    const bf16_t* kvb = MKV + (size_t)(b * MEMLEN) * 2048;
    for (int t = 0; t < MEMLEN / 64; ++t) {
        int lane_t = lane; asm volatile("" : "+v"(lane_t));
#pragma unroll
        for (int i = 0; i < 4; ++i) {
            const int c = wid + 8 * i;
            const u32x4 kv = *(const u32x4*)(kvb + (size_t)(t * 64 + lane_t) * 2048 + hh * 256 + c * 8);
            *(LAS u32x4*)(l3 + CK_OFF + c * 1024 + lane_t * 16) = kv;
            const int blk = wid + 8 * i, key = 16 * (blk & 3) + (lane_t >> 2), col = (blk >> 2) * 32 + (lane_t & 3) * 8;
            const u32x4 vv = *(const u32x4*)(kvb + (size_t)(t * 64 + key) * 2048 + 1024 + hh * 256 + col);
            *(LAS u32x4*)(l3 + CV_OFF + blk * 1024 + lane_t * 16) = vv;
        }
        __syncthreads();
        f32x16 p0, p1;
#pragma unroll
        for (int dg = 0; dg < 4; ++dg) {
            bf16x8 qf[4], k0[4], k1[4];
#pragma unroll
            for (int j = 0; j < 4; ++j) { const int d0 = dg * 4 + j; qf[j] = *(LAS const bf16x8*)(qp + d0 * 4096); k0[j] = *(LAS const bf16x8*)(kp + d0 * 2048); k1[j] = *(LAS const bf16x8*)(kp + d0 * 2048 + 512); }
            SCHED_PIN();
#pragma unroll
            for (int j = 0; j < 4; ++j) {
                if (dg == 0 && j == 0) { p0 = __builtin_amdgcn_mfma_f32_32x32x16_bf16(k0[j], qf[j], negm, 0, 0, 0); p1 = __builtin_amdgcn_mfma_f32_32x32x16_bf16(k1[j], qf[j], negm, 0, 0, 0); }
                else { p0 = __builtin_amdgcn_mfma_f32_32x32x16_bf16(k0[j], qf[j], p0, 0, 0, 0); p1 = __builtin_amdgcn_mfma_f32_32x32x16_bf16(k1[j], qf[j], p1, 0, 0, 0); }
            }
            SCHED_PIN();
        }
        { u32x4 pw[4]; softmax_part(p0, p1, negm, l, o, pw, wsf, t == 0, r32, hi); pv_part(pw, o, vp); }
        __syncthreads();
    }
    l = swapsum(l);
    scale_rows(o, wsf, 1.0f / l, r32, hi);
    int r32o = r32; asm volatile("" : "+v"(r32o));
    bf16_t* ob = O + (rowbase + q0 + qblk * 32) * 1024 + hh * 256 + half * 128 + r32o;
#pragma unroll
    for (int db = 0; db < 4; ++db)
#pragma unroll
        for (int r = 0; r < 16; ++r) ob[(size_t)crow(r, hi) * 1024 + 32 * db] = (bf16_t)(pk(o[db][r], 0.f) & 0xffffu);
}

constexpr int SG_V_OFF = 0, SG_ST_OFF = 32768, SG_S_OFF = 40960, SG_S_STRIDE = 144;
__device__ __forceinline__ void sgu_unit(LAS unsigned char* l3, bf16_t* SU, const bf16_t* SV, int chunk, const bf16_t* WsF, const float* Bs, const float* gam, const float* bet) {
    int tid = threadIdx.x; asm volatile("" : "+v"(tid));
    const int lane = tid & 63, r32 = lane & 31, hi = lane >> 5;
    const int wid = __builtin_amdgcn_readfirstlane(tid >> 6);
    LAS float* st = (LAS float*)(l3 + SG_ST_OFF);
    LAS float* Sx = (LAS float*)(l3 + SG_S_OFF);
    const size_t R0 = (size_t)chunk * 128;
#pragma unroll 1
    for (int rq = 0; rq < 4; ++rq) {
        u32x4 a[4], c[4];
#pragma unroll
        for (int j = 0; j < 4; ++j) { const bf16_t* p = SV + (R0 + wid * 16 + rq * 4 + j) * 1024 + lane * 8; a[j] = *(const u32x4*)p; c[j] = *(const u32x4*)(p + 512); }
        float s[4], q[4];
#pragma unroll
        for (int j = 0; j < 4; ++j) {
            s[j] = ((bflo(a[j].x) + bfhi(a[j].x)) + (bflo(a[j].y) + bfhi(a[j].y))) + ((bflo(a[j].z) + bfhi(a[j].z)) + (bflo(a[j].w) + bfhi(a[j].w)))
                 + ((bflo(c[j].x) + bfhi(c[j].x)) + (bflo(c[j].y) + bfhi(c[j].y))) + ((bflo(c[j].z) + bfhi(c[j].z)) + (bflo(c[j].w) + bfhi(c[j].w)));
        }
#pragma unroll
        for (int o = 1; o < 64; o <<= 1) {
#pragma unroll
            for (int j = 0; j < 4; ++j) s[j] += __shfl_xor(s[j], o);
        }
#pragma unroll
        for (int j = 0; j < 4; ++j) {
            const float mean = s[j] * (1.0f / 1024.0f); s[j] = mean;
            float d, qq = 0.f;
            d = bflo(a[j].x) - mean; qq += d * d; d = bfhi(a[j].x) - mean; qq += d * d; d = bflo(a[j].y) - mean; qq += d * d; d = bfhi(a[j].y) - mean; qq += d * d;
            d = bflo(a[j].z) - mean; qq += d * d; d = bfhi(a[j].z) - mean; qq += d * d; d = bflo(a[j].w) - mean; qq += d * d; d = bfhi(a[j].w) - mean; qq += d * d;
            d = bflo(c[j].x) - mean; qq += d * d; d = bfhi(c[j].x) - mean; qq += d * d; d = bflo(c[j].y) - mean; qq += d * d; d = bfhi(c[j].y) - mean; qq += d * d;
            d = bflo(c[j].z) - mean; qq += d * d; d = bfhi(c[j].z) - mean; qq += d * d; d = bflo(c[j].w) - mean; qq += d * d; d = bfhi(c[j].w) - mean; qq += d * d;
            q[j] = qq;
        }
#pragma unroll
        for (int o = 1; o < 64; o <<= 1) {
#pragma unroll
            for (int j = 0; j < 4; ++j) q[j] += __shfl_xor(q[j], o);
        }
        if (lane == 0) {
#pragma unroll
            for (int j = 0; j < 4; ++j) { const int row = wid * 16 + rq * 4 + j; st[row * 2] = s[j]; st[row * 2 + 1] = 1.0f / sqrtf(q[j] * (1.0f / 1024.0f) + 1e-5f); }
        }
    }
    __syncthreads();
    const int tb = wid >> 1, dh = wid & 1;
    const lds_cptr vp = (lds_cptr)l3 + SG_V_OFF + ((lane >> 4) & 1) * 32 + (lane & 3) * 8 + (4 * hi + ((lane & 15) >> 2)) * 64;
    const int srow = tid >> 2, sc = tid & 3;
#pragma unroll 1
    for (int g = 0; g < 8; ++g) {
        {
            const int s = srow, db = sc;
            const float mean = st[s * 2], rstd = st[s * 2 + 1];
            const bf16_t* p = SV + (R0 + s) * 1024 + g * 128 + db * 32;
            const float* gp = gam + g * 128 + db * 32; const float* bp = bet + g * 128 + db * 32;
#pragma unroll
            for (int c = 0; c < 4; ++c) {
                const u32x4 a = *(const u32x4*)(p + c * 8);
                const f32x4 g0 = *(const f32x4*)(gp + c * 8), g1 = *(const f32x4*)(gp + c * 8 + 4), b0 = *(const f32x4*)(bp + c * 8), b1 = *(const f32x4*)(bp + c * 8 + 4);
                u32x4 w;
                w.x = pk((bflo(a.x) - mean) * rstd * g0[0] + b0[0], (bfhi(a.x) - mean) * rstd * g0[1] + b0[1]);
                w.y = pk((bflo(a.y) - mean) * rstd * g0[2] + b0[2], (bfhi(a.y) - mean) * rstd * g0[3] + b0[3]);
                w.z = pk((bflo(a.z) - mean) * rstd * g1[0] + b1[0], (bfhi(a.z) - mean) * rstd * g1[1] + b1[1]);
                w.w = pk((bflo(a.w) - mean) * rstd * g1[2] + b1[2], (bfhi(a.w) - mean) * rstd * g1[3] + b1[3]);
                *(LAS u32x4*)(l3 + SG_V_OFF + (db * 8 + (s >> 4)) * 1024 + (s & 15) * 64 + c * 16) = w;
            }
        }
        u32x4 uu[4];
        bf16_t* up = SU + (R0 + srow) * 1024 + g * 128 + sc * 8;
#pragma unroll
        for (int i = 0; i < 4; ++i) uu[i] = *(const u32x4*)(up + 32 * i);
        __syncthreads();
        f32x16 acc[2];
#pragma unroll
        for (int j = 0; j < 2; ++j)
#pragma unroll
            for (int r = 0; r < 16; ++r) acc[j][r] = 0.f;
        const bf16_t* wf = WsF + ((size_t)(g * 4 + tb) * 8) * 512 + lane * 8;
        const int nks = 2 * tb + 2;
        for (int ks = 0; ks < nks; ++ks) {
            const bf16x8 aw = *(const bf16x8*)(wf + ks * 512);
#pragma unroll
            for (int j = 0; j < 2; ++j) {
                const int db = 2 * dh + j;
                const s16x4 lo = vtr(vp + (db * 8 + ks) * 1024), hh = vtr(vp + (db * 8 + ks) * 1024 + 512);
                const bf16x8 vf = (bf16x8){lo[0], lo[1], lo[2], lo[3], hh[0], hh[1], hh[2], hh[3]};
                acc[j] = __builtin_amdgcn_mfma_f32_32x32x16_bf16(aw, vf, acc[j], 0, 0, 0);
            }
        }
#pragma unroll
        for (int r = 0; r < 16; ++r) {
            const int tt = 32 * tb + crow(r, hi);
            const float bsv = Bs[g * 128 + tt];
#pragma unroll
            for (int j = 0; j < 2; ++j) Sx[tt * SG_S_STRIDE + 64 * dh + 32 * j + r32] = acc[j][r] + bsv;
        }
        __syncthreads();
#pragma unroll
        for (int i = 0; i < 4; ++i) {
            const LAS float* sp = Sx + srow * SG_S_STRIDE + (sc + 4 * i) * 8;
            const f32x4 s0 = *(LAS const f32x4*)sp, s1 = *(LAS const f32x4*)(sp + 4);
            u32x4 w;
            w.x = pk(bflo(uu[i].x) * s0[0], bfhi(uu[i].x) * s0[1]); w.y = pk(bflo(uu[i].y) * s0[2], bfhi(uu[i].y) * s0[3]);
            w.z = pk(bflo(uu[i].z) * s1[0], bfhi(uu[i].z) * s1[1]); w.w = pk(bflo(uu[i].w) * s1[2], bfhi(uu[i].w) * s1[3]);
            *(u32x4*)(up + 32 * i) = w;
        }
    }
    __syncthreads();
}

__device__ __forceinline__ unsigned pk2(float lo, float hi) { return pk(lo, hi); }
__device__ __forceinline__ void transpose_item(const float* W, int K, int N, bf16_t* WT, int k0, int n0, int out_row0, LAS float* scr, int lane) {
#pragma unroll 8
    for (int i = 0; i < 32; ++i) { const int kk = 2 * i + (lane >> 5); scr[kk * 33 + (lane & 31)] = W[(size_t)(k0 + kk) * N + n0 + (lane & 31)]; }
    asm volatile("s_waitcnt lgkmcnt(0)" ::: "memory");
    const int c = lane & 7;
#pragma unroll
    for (int j = 0; j < 4; ++j) { const int n = (lane >> 3) + 8 * j; const LAS float* s = scr + (8 * c) * 33 + n;
        u32x4 o; o.x = pk2(s[0 * 33], s[1 * 33]); o.y = pk2(s[2 * 33], s[3 * 33]); o.z = pk2(s[4 * 33], s[5 * 33]); o.w = pk2(s[6 * 33], s[7 * 33]);
        *(u32x4*)(WT + (size_t)(out_row0 + n) * K + k0 + 8 * c) = o; }
    asm volatile("s_waitcnt lgkmcnt(0)" ::: "memory");
}
__device__ __forceinline__ void row_to_bf16(const float* xrow, bf16_t* orow, int lane) {
    const f32x4* xr = (const f32x4*)xrow + lane; u32x2* o8 = (u32x2*)orow + lane;
#pragma unroll
    for (int j = 0; j < 4; ++j) { const f32x4 v = xr[64 * j]; u32x2 w; w.x = pk(v[0], v[1]); w.y = pk(v[2], v[3]); o8[64 * j] = w; }
}
__device__ __forceinline__ void ln_row(float* row, const float* g, const float* bta, bf16_t* obf, int lane) {
    f32x4* xr = (f32x4*)row + lane; f32x4 v[4]; float s = 0.f;
#pragma unroll
    for (int j = 0; j < 4; ++j) { v[j] = xr[64 * j]; s += (v[j][0] + v[j][1]) + (v[j][2] + v[j][3]); }
    const float mean = wave_sum(s) * (1.0f / 1024.0f); float q = 0.f;
#pragma unroll
    for (int j = 0; j < 4; ++j) { v[j] = v[j] - mean; q += (v[j][0] * v[j][0] + v[j][1] * v[j][1]) + (v[j][2] * v[j][2] + v[j][3] * v[j][3]); }
    const float rstd = 1.0f / sqrtf(wave_sum(q) * (1.0f / 1024.0f) + 1e-5f);
#pragma unroll
    for (int j = 0; j < 4; ++j) {
        const f32x4 gg = ((const f32x4*)g)[lane + 64 * j], bb = ((const f32x4*)bta)[lane + 64 * j];
        const f32x4 y = v[j] * rstd * gg + bb;
        xr[64 * j] = y;
        if (obf) { u32x2 w; w.x = pk(y[0], y[1]); w.y = pk(y[2], y[3]); ((u32x2*)obf)[lane + 64 * j] = w; }
    }
}
__device__ __forceinline__ void sincos_d(float ang, float& c, float& s) {
    const double a = (double)ang; const double q = rint(a * 0.6366197723675814); const double y = a - q * 1.5707963267948966; const double y2 = y * y;
    const double sp = y * (1.0 + y2 * (-1.0 / 6 + y2 * (1.0 / 120 + y2 * (-1.0 / 5040 + y2 * (1.0 / 362880 + y2 * (-1.0 / 39916800))))));
    const double cp = 1.0 + y2 * (-0.5 + y2 * (1.0 / 24 + y2 * (-1.0 / 720 + y2 * (1.0 / 40320 + y2 * (-1.0 / 3628800 + y2 * (1.0 / 479001600))))));
    const int qi = ((int)q) & 3;
    const double cc = (qi == 0) ? cp : (qi == 1) ? -sp : (qi == 2) ? -cp : sp;
    const double ss = (qi == 0) ? sp : (qi == 1) ? cp : (qi == 2) ? -sp : -cp;
    c = (float)cc; s = (float)ss;
}

#define XB_TMO      128
#define XB_XCNT(j)  (256  + 64 * (j))
#define XB_XSUB(j)  (1280 + 64 * (j))
#define XB_XGEN(j)  (2304 + 64 * (j))
#define XB_TOP      3328
#define XB_TOPGEN   3392
#define XCD_BAR_WORDS 3456
#define XB_SPIN_CAP (1u << 18)

__device__ __forceinline__ unsigned xb_ld(unsigned* p)              { return __hip_atomic_load(p, __ATOMIC_RELAXED, __HIP_MEMORY_SCOPE_AGENT); }
__device__ __forceinline__ unsigned xb_add(unsigned* p, unsigned v) { return __hip_atomic_fetch_add(p, v, __ATOMIC_RELAXED, __HIP_MEMORY_SCOPE_AGENT); }
__device__ __forceinline__ unsigned xb_xcc_id() { return (unsigned)__builtin_amdgcn_s_getreg((3 << 11) | 20) & 0xFu; }
#define XB_SPIN(cond, bar) do { unsigned _sp = 0; while (cond) { __builtin_amdgcn_s_sleep(1); \
    if ((++_sp & 255u) == 0u) { if (xb_ld(&(bar)[XB_TMO])) break; if (_sp > XB_SPIN_CAP) { atomicAdd(&(bar)[XB_TMO], 1u); break; } } } } while (0)

struct XcdBarrier {
    unsigned* bar; unsigned x;
    volatile LAS unsigned* st;
};

__device__ __forceinline__ XcdBarrier xcd_barrier_post(unsigned* bar, volatile LAS unsigned* st) {
    XcdBarrier b; b.bar = bar; b.x = xb_xcc_id(); b.st = st;
    if (threadIdx.x == 0) (void)xb_add(&bar[XB_XCNT(b.x)], 1u);
    return b;
}
__device__ __forceinline__ void xcd_barrier_complete(unsigned* bar, unsigned x, unsigned& nloc, unsigned& nx) {
    const unsigned G = gridDim.x * gridDim.y * gridDim.z;
    unsigned sum, cnt, mine, sp = 0u;
    for (;;) {
        sum = 0u; cnt = 0u; mine = 0u;
#pragma unroll
        for (unsigned j = 0; j < 16; ++j) { const unsigned c = xb_ld(&bar[XB_XCNT(j)]); sum += c; cnt += (c > 0u) ? 1u : 0u; mine = (j == x) ? c : mine; }
        if (sum == G) break;
        __builtin_amdgcn_s_sleep(1);
        if ((++sp & 255u) == 0u) { if (xb_ld(&bar[XB_TMO])) break; if (sp > XB_SPIN_CAP) { atomicAdd(&bar[XB_TMO], 1u); break; } }
    }
    nloc = mine > 0u ? mine : 1u; nx = cnt > 0u ? cnt : 1u;
}

__device__ __forceinline__ void xcd_barrier(const XcdBarrier& b) {
    asm volatile("s_waitcnt vmcnt(0)" ::: "memory");
    __syncthreads();
    if (threadIdx.x == 0) {
        unsigned* bar = b.bar;
        __builtin_amdgcn_s_waitcnt(0);
        unsigned nloc = b.st[0], nx = b.st[1];
        if (nloc == 0u) { xcd_barrier_complete(bar, b.x, nloc, nx); b.st[0] = nloc; b.st[1] = nx; }
        const unsigned old = xb_add(&bar[XB_XSUB(b.x)], 1u);
        const unsigned gen = old / nloc;
        if (old + 1u == (gen + 1u) * nloc) {
            __builtin_amdgcn_fence(__ATOMIC_RELEASE, "agent");
            asm volatile("s_waitcnt vmcnt(0)" ::: "memory");
            const unsigned og = xb_add(&bar[XB_TOP], 1u);
            const unsigned tg = og / nx;
            if (og + 1u == (tg + 1u) * nx) xb_add(&bar[XB_TOPGEN], 1u);
            else XB_SPIN(xb_ld(&bar[XB_TOPGEN]) == tg, bar);
            __builtin_amdgcn_fence(__ATOMIC_ACQUIRE, "agent");
            xb_add(&bar[XB_XGEN(b.x)], 1u);
            asm volatile("s_waitcnt vmcnt(0)" ::: "memory");
        } else {
            XB_SPIN(xb_ld(&bar[XB_XGEN(b.x)]) == gen, bar);
            __builtin_amdgcn_fence(__ATOMIC_ACQUIRE, "agent");
            asm volatile("s_waitcnt vmcnt(0)" ::: "memory");
        }
    }
    __syncthreads();
}

#ifndef PH_MASK
#define PH_MASK 0x1ff
#endif
__device__ __forceinline__ const void* karg_ptr(int k) {
    const char* p = (const char*)__builtin_amdgcn_kernarg_segment_ptr(); asm volatile("" : "+s"(p));
    const unsigned long long v = *(const unsigned long long*)(p + 8 * k);
    const unsigned lo = __builtin_amdgcn_readfirstlane((unsigned)v), hi = __builtin_amdgcn_readfirstlane((unsigned)(v >> 32));
    typedef __attribute__((address_space(1))) const void* gptr_t;
    return (const void*)(gptr_t)(((unsigned long long)hi << 32) | lo);
}
struct Args { const void* in[24]; float* out; unsigned char* ws; };

#define KARG(k) karg_ptr(k)
__global__ void __launch_bounds__(512, 2) fwd_kernel(Args a) {
    extern __shared__ __attribute__((aligned(16))) unsigned char lds[];
    cg::grid_group grid = cg::this_grid();
    const int tid = threadIdx.x, lane = tid & 63, wave = __builtin_amdgcn_readfirstlane(tid >> 6);
    const int G = gridDim.x, bx = blockIdx.x;
    const int vcu = (G % 8 == 0) ? (bx % 8) * (G / 8) + bx / 8 : bx;
    LAS unsigned char* l3 = (LAS unsigned char*)lds;
    if (tid < 16) ((LAS unsigned*)(l3 + LDS_CTL_OFF))[tid] = 0u;
    __syncthreads();
    XcdBarrier xbar = xcd_barrier_post((unsigned*)((unsigned char*)KARG(25) + WS_CTL), (volatile LAS unsigned*)(l3 + LDS_CTL_OFF));
#define DECL_WS unsigned char* ws = (unsigned char*)KARG(25); float* out = (float*)KARG(24); (void)ws; (void)out; \
    bf16_t* WT_IN = (bf16_t*)(ws + WS_WIN); bf16_t* WT_MKV = (bf16_t*)(ws + WS_WMKV); bf16_t* WT_BR = (bf16_t*)(ws + WS_WBR); bf16_t* WT_OUT = (bf16_t*)(ws + WS_WOUT); \
    bf16_t* WT_FFI = (bf16_t*)(ws + WS_WFFI); bf16_t* WT_FFO = (bf16_t*)(ws + WS_WFFO); bf16_t* MKV = (bf16_t*)(ws + WS_MKV); bf16_t* MEMB = (bf16_t*)(ws + WS_MEMB); \
    float* ROPE = (float*)(ws + WS_ROPE); bf16_t* WSF = (bf16_t*)(ws + WS_WSF); (void)WSF; \
    bf16_t* XB = (bf16_t*)(ws + 1 * SLOT); bf16_t* QB = (bf16_t*)(ws + 2 * SLOT); bf16_t* KB = (bf16_t*)(ws + 3 * SLOT); bf16_t* VB = (bf16_t*)(ws + 4 * SLOT); \
    bf16_t* SUB = (bf16_t*)(ws + 5 * SLOT); bf16_t* SVB = (bf16_t*)(ws + 6 * SLOT); bf16_t* XQB = (bf16_t*)(ws + 7 * SLOT); \
    bf16_t* ODA = (bf16_t*)out; bf16_t* OXA = (bf16_t*)out + SLOT_ELEMS; \
    bf16_t* GB = QB; bf16_t* MGB = KB; bf16_t* X1B = VB; bf16_t* HB = SUB; \
    (void)WT_IN; (void)WT_MKV; (void)WT_BR; (void)WT_OUT; (void)WT_FFI; (void)WT_FFO; (void)MKV; (void)MEMB; (void)ROPE; (void)XB; (void)QB; (void)KB; (void)VB; (void)SUB; (void)SVB; (void)XQB; \
    (void)ODA; (void)OXA; (void)GB; (void)MGB; (void)X1B; (void)HB;
#if (PH_MASK >> 0) & 1
    {
        DECL_WS
        const float* x = (const float*)KARG(0); const float* mem = (const float*)KARG(1); const int* positions = (const int*)KARG(2); const float* w_in = (const float*)KARG(3);
        const float* w_mkv = (const float*)KARG(13); const float* w_br0 = (const float*)KARG(14); const float* w_br1 = (const float*)KARG(15); const float* w_br2 = (const float*)KARG(16);
        const float* w_out = (const float*)KARG(17); const float* w_ffi = (const float*)KARG(20); const float* w_ffo = (const float*)KARG(21);
        LAS float* scr = (LAS float*)(l3 + wave * 16384);
        const int gw = vcu * 8 + wave, NGW = G * 8;
        constexpr int I_IN = 16 * 288, I_MKV = 16 * 64, I_SQ = 16 * 32, I_FFI = 16 * 176, I_FFO = 44 * 32;
        constexpr int NITEMS = I_IN + I_MKV + 4 * I_SQ + I_FFI + I_FFO;
        for (int it = gw; it < NITEMS; it += NGW) {
            int r = it;
            if (r < I_IN) { const int nb = r % 288, kb = r / 288; transpose_item(w_in, 1024, NIN, WT_IN, kb * 64, nb * 32, nb * 32, scr, lane); continue; } r -= I_IN;
            if (r < I_MKV) { const int nb = r % 64, kb = r / 64; transpose_item(w_mkv, 1024, 2048, WT_MKV, kb * 64, nb * 32, nb * 32, scr, lane); continue; } r -= I_MKV;
            if (r < 3 * I_SQ) { const int w = r / I_SQ, rr = r % I_SQ, nb = rr % 32, kb = rr / 32; transpose_item(w == 0 ? w_br0 : (w == 1 ? w_br1 : w_br2), 1024, 1024, WT_BR + (size_t)w * 1024 * 1024, kb * 64, nb * 32, nb * 32, scr, lane); continue; } r -= 3 * I_SQ;
            if (r < I_SQ) { const int nb = r % 32, kb = r / 32; transpose_item(w_out, 1024, 1024, WT_OUT, kb * 64, nb * 32, nb * 32, scr, lane); continue; } r -= I_SQ;
            if (r < I_FFI) { const int nb = r % 176, kb = r / 176; const int n0 = nb * 32, hf = n0 / DFF, jn = n0 % DFF;
                transpose_item(w_ffi, 1024, 2 * DFF, WT_FFI, kb * 64, n0, 256 * (jn / 128) + 128 * hf + (jn % 128), scr, lane); continue; } r -= I_FFI;
            { const int nb = r % 32, kb = r / 32; transpose_item(w_ffo, DFF, 1024, WT_FFO, kb * 64, nb * 32, nb * 32, scr, lane); }
        }
        for (int m = gw; m < MTOK; m += NGW) row_to_bf16(x + (size_t)m * 1024, XB + (size_t)m * 1024, lane);
        for (int m = gw; m < BATCH * MEMLEN; m += NGW) row_to_bf16(mem + (size_t)m * 1024, MEMB + (size_t)m * 1024, lane);
        {
            const float* sg_ws = (const float*)KARG(11);
            for (int idx = vcu * 512 + tid; idx < 8 * 4 * 8 * 64; idx += G * 512) {
                const int ln = idx & 63, ks = (idx >> 6) & 7, tbb = (idx >> 9) & 3, gg = idx >> 11;
                const int trow = 32 * tbb + (ln & 31), s0 = 16 * ks + 4 * (ln >> 5);
                const float* wrow = sg_ws + ((size_t)gg * 128 + trow) * 128;
                f32x4 wa = *(const f32x4*)(wrow + s0), wb = *(const f32x4*)(wrow + s0 + 8);
#pragma unroll
                for (int j = 0; j < 4; ++j) { if (s0 + j > trow) wa[j] = 0.f; if (s0 + 8 + j > trow) wb[j] = 0.f; }
                u32x4 aw; aw.x = pk(wa[0], wa[1]); aw.y = pk(wa[2], wa[3]); aw.z = pk(wb[0], wb[1]); aw.w = pk(wb[2], wb[3]);
                *(u32x4*)(WSF + (size_t)idx * 8) = aw;
            }
        }
        for (int idx = (vcu * 512 + tid); idx < MTOK * 8; idx += G * 512) {
            const int row = idx >> 3, i = idx & 7;
            const float invf = (i == 0) ? 1.0f : (i == 1) ? 0.1939227432012558f : (i == 2) ? 0.03760603070259094f : (i == 3) ? 0.007292664609849453f :
                               (i == 4) ? 0.0014142135623842478f : (i == 5) ? 0.00027424818836152554f : (i == 6) ? 5.3182957344688475e-05f : 1.0313385246263351e-05f;
            const float ang = (float)positions[row] * invf; float c, s; sincos_d(ang, c, s);
            ROPE[(size_t)row * 16 + i] = c; ROPE[(size_t)row * 16 + 8 + i] = s;
        }
    }
    grid.sync();
#endif
#if (PH_MASK >> 1) & 1
    {
        DECL_WS
        pg8::Gemm g{XB, WT_IN, MTOK, 6144, 1024}; pg8::StaticOrder S; S.init(MTOK, 6144, G, bx);
        pg8::EpiA E{QB, ROPE};
        pg8::gemm_phase<pg8::EpiA, pg8::StaticOrder, true, true>(l3, g, S, E);
        pg8::Gemm g2{MEMB, WT_MKV, BATCH * MEMLEN, 2048, 1024}; pg8::StaticOrder S2; S2.init(BATCH * MEMLEN, 2048, G, bx);
        pg8::EpiStore<0> E2{MKV, 2048};
        pg8::gemm_phase<pg8::EpiStore<0>, pg8::StaticOrder, true, true>(l3, g2, S2, E2);
    }
    xcd_barrier(xbar);
#endif
#if (PH_MASK >> 2) & 1
    {
        DECL_WS
        const float* lq1 = (const float*)KARG(4); const float* lk1 = (const float*)KARG(5); const float* lq2 = (const float*)KARG(6); const float* lk2 = (const float*)KARG(7);
        const float* subg = (const float*)KARG(8); const float* sg_g = (const float*)KARG(9); const float* sg_b = (const float*)KARG(10); const float* sg_bs = (const float*)KARG(12);
        float lam;
        { const float a1 = wave_sum(lq1[lane] * lk1[lane]), a2 = wave_sum(lq2[lane] * lk2[lane]); lam = expf(a1) - expf(a2) + 0.2f; }
#ifndef DIFF_REP
#define DIFF_REP 1
#endif
        for (int rep = 0; rep < DIFF_REP; ++rep)
        for (int i = 7; i >= 0; --i)
            for (int v = vcu; v < 256; v += G) {
                const int bh = v >> 3, s = v & 7, qb = 16 * (i >> 1) + ((i & 1) ? 15 - s : s);
                diff_unit(l3, QB, KB, VB, ODA, bh >> 3, bh & 7, qb, lam, subg);
            }
        for (int c = vcu; c < 256; c += G) sgu_unit(l3, SUB, SVB, c, WSF, sg_bs, sg_g, sg_b);
#ifndef CROSS_REP
#define CROSS_REP 1
#endif
        for (int rep = 0; rep < CROSS_REP; ++rep)
        for (int i = 0; i < 4; ++i)
            for (int v = vcu; v < 256; v += G) {
                const int c = v * 4 + i, bhh = c >> 6, qb = c & 63;
                cross_unit(l3, XQB, MKV, OXA, bhh >> 2, bhh & 3, qb);
                __syncthreads();
            }
    }
    xcd_barrier(xbar);
#endif
#if (PH_MASK >> 3) & 1
    {
        DECL_WS
#pragma unroll 1
        for (int step = 0; step < 6; ++step) {
            const int b = step >> 1; const bool isg = (step & 1) == 0;
            pg8::StaticOrder S; S.init(MTOK, 1024, G, bx);
            const bf16_t* Ap = isg ? (const bf16_t*)XB : (b == 0 ? (const bf16_t*)ODA : (b == 1 ? (const bf16_t*)SUB : (const bf16_t*)OXA));
            const bf16_t* Bp = isg ? (const bf16_t*)(WT_IN + (size_t)(6144 + 1024 * b) * 1024) : (const bf16_t*)(WT_BR + (size_t)b * 1024 * 1024);
            pg8::Gemm gg{Ap, Bp, MTOK, 1024, 1024};
            pg8::EpiGM Eg{GB, MGB, isg ? 0 : (b == 0 ? 1 : 2)};
            pg8::gemm_phase<pg8::EpiGM, pg8::StaticOrder, true, true>(l3, gg, S, Eg);
        }
    }
    xcd_barrier(xbar);
#endif
#if (PH_MASK >> 4) & 1
    {
        DECL_WS
        const float* x = (const float*)KARG(0);
        pg8::StaticOrder S; S.init(MTOK, 1024, G, bx);
        pg8::Gemm g{MGB, WT_OUT, MTOK, 1024, 1024};
        pg8::EpiRes32 E{x, out, ALPHA_RES};
        pg8::gemm_phase<pg8::EpiRes32, pg8::StaticOrder, true, true>(l3, g, S, E);
    }
    xcd_barrier(xbar);
#endif
#if (PH_MASK >> 5) & 1
    { DECL_WS const float* ln1g = (const float*)KARG(18); const float* ln1b = (const float*)KARG(19);
      const int gw = vcu * 8 + wave, NGW = G * 8; for (int m = gw; m < MTOK; m += NGW) ln_row(out + (size_t)m * 1024, ln1g, ln1b, X1B + (size_t)m * 1024, lane); }
    xcd_barrier(xbar);
#endif
#if (PH_MASK >> 6) & 1
    {
        DECL_WS
        pg8::StaticOrder S; S.init(MTOK, 2 * DFF, G, bx);
        pg8::Gemm g{X1B, WT_FFI, MTOK, 2 * DFF, 1024};
        pg8::EpiSwiglu E{HB};
        pg8::gemm_phase<pg8::EpiSwiglu, pg8::StaticOrder, true, true>(l3, g, S, E);
    }
    xcd_barrier(xbar);
#endif
#if (PH_MASK >> 7) & 1
    {
        DECL_WS
        pg8::StaticOrder S; S.init(MTOK, 1024, G, bx);
        pg8::Gemm g{HB, WT_FFO, MTOK, 1024, DFF};
        pg8::EpiRes32 E{out, out, ALPHA_RES};
        pg8::gemm_phase<pg8::EpiRes32, pg8::StaticOrder, true, true>(l3, g, S, E);
    }
    xcd_barrier(xbar);
#endif
#if (PH_MASK >> 8) & 1
    { DECL_WS const float* ln2g = (const float*)KARG(22); const float* ln2b = (const float*)KARG(23);
      const int gw = vcu * 8 + wave, NGW = G * 8; for (int m = gw; m < MTOK; m += NGW) ln_row(out + (size_t)m * 1024, ln2g, ln2b, nullptr, lane); }
#endif
}

extern "C" void kernel_launch(void* const* d_in, const int* in_sizes, int n_in, void* d_out, int out_size, void* d_ws, size_t ws_size, hipStream_t stream) {
    static int grid = 0;
    if (grid == 0) {
        int dev = 0, cus = 0, per_cu = 0;
        hipGetDevice(&dev);
        hipDeviceGetAttribute(&cus, hipDeviceAttributeMultiprocessorCount, dev);
        hipFuncSetAttribute((const void*)fwd_kernel, hipFuncAttributeMaxDynamicSharedMemorySize, LDS_BYTES);
        hipOccupancyMaxActiveBlocksPerMultiprocessor(&per_cu, (const void*)fwd_kernel, 512, LDS_BYTES);
        (void)hipGetLastError();
        if (per_cu < 1) per_cu = 1;
        grid = cus;
        if (n_in != 24 || ws_size < 8 * SLOT) fprintf(stderr, "kernel_launch: unexpected n_in %d or ws_size %zu\n", n_in, ws_size);
    }
    (void)hipMemsetAsync((unsigned char*)d_ws + WS_CTL, 0, CTL_BYTES, stream);
    Args a{};
    for (int i = 0; i < 24; ++i) a.in[i] = d_in[i];
    a.out = (float*)d_out; a.ws = (unsigned char*)d_ws;
    void* args[] = {&a};
    hipError_t e = hipLaunchCooperativeKernel((const void*)fwd_kernel, dim3(grid), dim3(512), args, LDS_BYTES, stream);
    if (e != hipSuccess) fprintf(stderr, "cooperative launch failed: %s (grid %d)\n", hipGetErrorString(e), grid);
}
```
